# Optimizing an MI355X kernel written in HIP

```python
import math
import jax, jax.numpy as jnp
from jax import lax
import numpy as np

D_MODEL = 1024
BATCH = 4
SEQ = 4096
DEPTH = 4

GRID_W = 64
CTX_LEN = 256
N_MIXERS = 3
N_S5 = (DEPTH + 2) // 3
N_SC = (DEPTH + 1) // 3
N_CF = DEPTH // 3
S5_GROUP_CH = 16
S5_GROUPS = D_MODEL // S5_GROUP_CH
S5_STATE = 64
DT_MIN = 1e-3
DT_MAX = 1e-1
SC_WIDTH = 3
CF_WIDTH = 31
N_EXPERTS = 32
TOP_K = 4
D_EXPERT = D_MODEL
SWIGLU_LIMIT = 7.0
SWIGLU_ALPHA = 1.702
MOE_BLOCK = 256
RMS_EPS = 1e-6
LN_EPS = 1e-5

kernel_name = 'hybrid_s5_shortconv_conformer_moe_dit'


def rms_norm(x, g):
    xf = x.astype(jnp.float32)
    y = xf * lax.rsqrt(jnp.mean(xf * xf, axis=-1, keepdims=True) + RMS_EPS)
    return (y * g.astype(jnp.float32)).astype(x.dtype)


def layer_norm(x, g, b):
    xf = x.astype(jnp.float32)
    mu = jnp.mean(xf, axis=-1, keepdims=True)
    xc = xf - mu
    y = xc * lax.rsqrt(jnp.mean(xc * xc, axis=-1, keepdims=True) + LN_EPS)
    return (y * g.astype(jnp.float32) + b.astype(jnp.float32)).astype(x.dtype)


def depthwise_conv(x, k):
    nsp = x.ndim - 2
    spec = ('NWC', 'WIO', 'NWC') if nsp == 1 else ('NHWC', 'HWIO', 'NHWC')
    rhs = k.reshape(k.shape[:-1] + (1, k.shape[-1])).astype(x.dtype)
    return lax.conv_general_dilated(x, rhs, window_strides=(1,) * nsp, padding='SAME',
                                    dimension_numbers=spec, feature_group_count=x.shape[-1])


def _linrec(left, right):
    a1, b1 = left
    a2, b2 = right
    return a1 * a2, a2 * b1 + b2


def _diag_scan(bu, lam_bar, h0, reverse):
    length = bu.shape[0]
    if h0 is not None:
        bu = bu.at[length - 1 if reverse else 0].add(lam_bar * h0)
    a = jnp.broadcast_to(lam_bar, (length, 1) + lam_bar.shape)
    _, s = lax.associative_scan(_linrec, (a, bu), reverse=reverse, axis=0)
    return s


def s5_mixer(h_ctx, h_lat, lam_re, lam_im, log_dt, b_re, b_im, c_re, c_im, d, glu_w, glu_b, with_ctx_out):
    f32 = jnp.float32
    dtype = h_lat.dtype
    lam = lax.complex(lam_re.astype(f32), lam_im.astype(f32))
    dt = jnp.exp(log_dt.astype(f32))[..., None]
    lam_bar = jnp.exp(lam * dt)
    b_bar = ((lam_bar - 1.0) / lam)[..., None] * lax.complex(b_re.astype(f32), b_im.astype(f32))
    c_mat = lax.complex(c_re.astype(f32), c_im.astype(f32))
    d_g = d.astype(f32).reshape(S5_GROUPS, S5_GROUP_CH)

    def to_groups(h):
        bsz, length, _ = h.shape
        return h.astype(f32).reshape(bsz, length, S5_GROUPS, S5_GROUP_CH)

    u_ctx, u_lat = to_groups(h_ctx), to_groups(h_lat)
    uc_ctx, uc_lat = u_ctx.astype(jnp.complex64), u_lat.astype(jnp.complex64)
    y_lat = u_lat * d_g
    y_ctx = u_ctx * d_g if with_ctx_out else None
    for k in range(2):
        rev = k == 1
        s_c = _diag_scan(jnp.einsum('blgc,gpc->lbgp', uc_ctx, b_bar[k]), lam_bar[k], None, rev)
        h_end = s_c[0] if rev else s_c[-1]
        s_l = _diag_scan(jnp.einsum('blgc,gpc->lbgp', uc_lat, b_bar[k]), lam_bar[k], h_end, rev)
        y_lat = y_lat + jnp.real(jnp.einsum('lbgp,gcp->blgc', s_l, c_mat[k]))
        if with_ctx_out:
            y_ctx = y_ctx + jnp.real(jnp.einsum('lbgp,gcp->blgc', s_c, c_mat[k]))

    def glu(y):
        bsz, length = y.shape[0], y.shape[1]
        z = jax.nn.gelu(y.reshape(bsz, length, D_MODEL)).astype(dtype) @ glu_w + glu_b
        a, g = jnp.split(z, 2, axis=-1)
        return a * jax.nn.sigmoid(g)

    return (glu(y_ctx) if with_ctx_out else None), glu(y_lat)


def short_conv_mixer(h, w_in, conv_w, w_out, rows):
    v, gate_b, gate_c = jnp.split(h @ w_in, 3, axis=-1)
    u = gate_c * v
    if rows is None:
        u = depthwise_conv(u, conv_w)
    else:
        bsz, length, ch = u.shape
        u = depthwise_conv(u.reshape(bsz, rows, GRID_W, ch), conv_w[None]).reshape(bsz, length, ch)
    return (gate_b * u) @ w_out


def conformer_conv(h, pw1_w, pw1_b, dw_w, dw_b, ln_g, ln_b, pw2_w, pw2_b, rows):
    a, g = jnp.split(h @ pw1_w + pw1_b, 2, axis=-1)
    u = a * jax.nn.sigmoid(g)
    if rows is None:
        u = depthwise_conv(u, dw_w)
    else:
        bsz, length, ch = u.shape
        u = depthwise_conv(u.reshape(bsz, rows, GRID_W, ch), dw_w[:, None, :]).reshape(bsz, length, ch)
    u = jax.nn.silu(layer_norm(u + dw_b, ln_g, ln_b))
    return u @ pw2_w + pw2_b


def moe_ffn(xt, router_w, router_b, w_gu, b_gu, w_down, b_down):
    n_tok, dm = xt.shape
    logits = (xt @ router_w).astype(jnp.float32) + router_b.astype(jnp.float32)
    top_vals, top_idx = lax.top_k(logits, TOP_K)
    gates = jax.nn.softmax(top_vals, axis=-1)
    e_flat = top_idx.reshape(-1)
    tok_flat = jnp.repeat(jnp.arange(n_tok, dtype=jnp.int32), TOP_K)
    g_flat = gates.reshape(-1)
    order = jnp.argsort(e_flat)
    e_sorted = e_flat[order]
    counts = jnp.bincount(e_flat, length=N_EXPERTS)
    padded = (counts + MOE_BLOCK - 1) // MOE_BLOCK * MOE_BLOCK
    start = jnp.cumsum(counts) - counts
    p_end = jnp.cumsum(padded)
    p_start = p_end - padded
    dest = p_start[e_sorted] + (jnp.arange(n_tok * TOP_K) - start[e_sorted])
    n_blocks = (n_tok * TOP_K + N_EXPERTS * (MOE_BLOCK - 1) + MOE_BLOCK - 1) // MOE_BLOCK
    n_rows = n_blocks * MOE_BLOCK
    row_tok = jnp.full((n_rows,), n_tok, dtype=jnp.int32).at[dest].set(tok_flat[order])
    row_gate = jnp.zeros((n_rows,), jnp.float32).at[dest].set(g_flat[order])
    block_expert = jnp.minimum(jnp.searchsorted(p_end, jnp.arange(n_blocks) * MOE_BLOCK, side='right'),
                               N_EXPERTS - 1)
    xpad = jnp.concatenate([xt, jnp.zeros((1, dm), xt.dtype)], axis=0)
    xb = xpad[row_tok].reshape(n_blocks, MOE_BLOCK, dm)

    def expert_block(args):
        xblk, e = args
        gu = xblk @ w_gu[e] + b_gu[e]
        gate = jnp.minimum(gu[:, 0::2], SWIGLU_LIMIT)
        up = jnp.clip(gu[:, 1::2], -SWIGLU_LIMIT, SWIGLU_LIMIT)
        act = gate * jax.nn.sigmoid(SWIGLU_ALPHA * gate) * (up + 1.0)
        return act @ w_down[e] + b_down[e]

    yb = lax.map(expert_block, (xb, block_expert)).reshape(n_rows, dm)
    yb = yb * row_gate[:, None].astype(yb.dtype)
    return jax.ops.segment_sum(yb, row_tok, num_segments=n_tok + 1)[:n_tok]


def setup_inputs(seed: int = 0) -> dict:
    key = jax.random.key(seed)
    ks = iter(jax.random.split(key, 40))
    f32 = jnp.float32
    D, G, P, Cg, E, F = D_MODEL, S5_GROUPS, S5_STATE, S5_GROUP_CH, N_EXPERTS, D_EXPERT

    def nrm(shape, scale):
        return scale * jax.random.normal(next(ks), shape, f32)

    n_idx = jnp.arange(P, dtype=f32)
    return {
        'x': nrm((BATCH, SEQ, D), 1.0),
        'c': nrm((BATCH, D), 1.0),
        'ctx': nrm((BATCH, CTX_LEN, D), 1.0),
        'c_ctx': nrm((D,), 1.0),
        'ada_w': nrm((DEPTH, D, 6 * D), 0.5 * D ** -0.5),
        'ada_b': nrm((DEPTH, 6 * D), 0.01),
        'norm1_g': 1.0 + nrm((DEPTH, D), 0.02),
        'norm2_g': 1.0 + nrm((DEPTH, D), 0.02),
        'final_g': 1.0 + nrm((D,), 0.02),
        's5_lambda_re': -0.5 + nrm((N_S5, 2, G, P), 0.01),
        's5_lambda_im': math.pi * n_idx + nrm((N_S5, 2, G, P), 0.01),
        's5_log_dt': jax.random.uniform(next(ks), (N_S5, 2, G), f32, math.log(DT_MIN), math.log(DT_MAX)),
        's5_b_re': nrm((N_S5, 2, G, P, Cg), Cg ** -0.5),
        's5_b_im': nrm((N_S5, 2, G, P, Cg), Cg ** -0.5),
        's5_c_re': nrm((N_S5, 2, G, Cg, P), 0.5),
        's5_c_im': nrm((N_S5, 2, G, Cg, P), 0.5),
        's5_d': nrm((N_S5, D), 0.5),
        's5_glu_w': nrm((N_S5, D, 2 * D), D ** -0.5),
        's5_glu_b': nrm((N_S5, 2 * D), 0.01),
        'sc_w_in': nrm((N_SC, D, 3 * D), D ** -0.5),
        'sc_conv_w': nrm((N_SC, SC_WIDTH, D), SC_WIDTH ** -0.5),
        'sc_w_out': nrm((N_SC, D, D), D ** -0.5),
        'cf_pw1_w': nrm((N_CF, D, 2 * D), D ** -0.5),
        'cf_pw1_b': nrm((N_CF, 2 * D), 0.01),
        'cf_dw_w': nrm((N_CF, CF_WIDTH, D), CF_WIDTH ** -0.5),
        'cf_dw_b': nrm((N_CF, D), 0.01),
        'cf_ln_g': 1.0 + nrm((N_CF, D), 0.02),
        'cf_ln_b': nrm((N_CF, D), 0.01),
        'cf_pw2_w': nrm((N_CF, D, D), D ** -0.5),
        'cf_pw2_b': nrm((N_CF, D), 0.01),
        'moe_router_w': nrm((DEPTH, D, E), D ** -0.5),
        'moe_router_b': nrm((DEPTH, E), 0.01),
        'moe_w_gu': nrm((DEPTH, E, D, 2 * F), D ** -0.5),
        'moe_b_gu': nrm((DEPTH, E, 2 * F), 0.01),
        'moe_w_down': nrm((DEPTH, E, F, D), F ** -0.5),
        'moe_b_down': nrm((DEPTH, E, D), 0.01),
    }


def reference(x, c, ctx, c_ctx, ada_w, ada_b, norm1_g, norm2_g, final_g,
              s5_lambda_re, s5_lambda_im, s5_log_dt, s5_b_re, s5_b_im, s5_c_re, s5_c_im, s5_d,
              s5_glu_w, s5_glu_b, sc_w_in, sc_conv_w, sc_w_out,
              cf_pw1_w, cf_pw1_b, cf_dw_w, cf_dw_b, cf_ln_g, cf_ln_b, cf_pw2_w, cf_pw2_b,
              moe_router_w, moe_router_b, moe_w_gu, moe_b_gu, moe_w_down, moe_b_down):
    bsz, seq, dm = x.shape
    n_ctx = ctx.shape[1]
    rows = seq // GRID_W
    cond_lat = jax.nn.silu(c)
    cond_ctx = jax.nn.silu(c_ctx)
    x_lat, x_ctx = x, ctx
    for i in range(DEPTH):
        last = i == DEPTH - 1
        kind, j = i % N_MIXERS, i // N_MIXERS
        need_ctx = (kind == 0) or (not last)
        sh1, sc1, g1, sh2, sc2, g2 = jnp.split((cond_lat @ ada_w[i] + ada_b[i])[:, None, :], 6, axis=-1)
        h_lat = rms_norm(x_lat, norm1_g[i]) * (1.0 + sc1) + sh1
        if need_ctx:
            csh1, csc1, cg1, csh2, csc2, cg2 = jnp.split(cond_ctx @ ada_w[i] + ada_b[i], 6, axis=-1)
            h_ctx = rms_norm(x_ctx, norm1_g[i]) * (1.0 + csc1) + csh1
        if kind == 0:
            y_ctx, y_lat = s5_mixer(h_ctx, h_lat, s5_lambda_re[j], s5_lambda_im[j], s5_log_dt[j],
                                    s5_b_re[j], s5_b_im[j], s5_c_re[j], s5_c_im[j], s5_d[j],
                                    s5_glu_w[j], s5_glu_b[j], not last)
        elif kind == 1:
            y_lat = short_conv_mixer(h_lat, sc_w_in[j], sc_conv_w[j], sc_w_out[j], rows)
            y_ctx = None if last else short_conv_mixer(h_ctx, sc_w_in[j], sc_conv_w[j], sc_w_out[j], None)
        else:
            cf_args = (cf_pw1_w[j], cf_pw1_b[j], cf_dw_w[j], cf_dw_b[j], cf_ln_g[j], cf_ln_b[j], cf_pw2_w[j], cf_pw2_b[j])
            y_lat = conformer_conv(h_lat, *cf_args, rows)
            y_ctx = None if last else conformer_conv(h_ctx, *cf_args, None)
        x_lat = x_lat + g1 * y_lat
        moe_args = (moe_router_w[i], moe_router_b[i], moe_w_gu[i], moe_b_gu[i], moe_w_down[i], moe_b_down[i])
        f_lat = rms_norm(x_lat, norm2_g[i]) * (1.0 + sc2) + sh2
        if last:
            x_lat = x_lat + g2 * moe_ffn(f_lat.reshape(-1, dm), *moe_args).reshape(bsz, seq, dm)
        else:
            x_ctx = x_ctx + cg1 * y_ctx
            f_ctx = rms_norm(x_ctx, norm2_g[i]) * (1.0 + csc2) + csh2
            tokens = jnp.concatenate([f_ctx.reshape(-1, dm), f_lat.reshape(-1, dm)], axis=0)
            out = moe_ffn(tokens, *moe_args)
            n_c = bsz * n_ctx
            x_ctx = x_ctx + cg2 * out[:n_c].reshape(bsz, n_ctx, dm)
            x_lat = x_lat + g2 * out[n_c:].reshape(bsz, seq, dm)
    return rms_norm(x_lat, final_g)
```

```cpp
#include <hip/hip_runtime.h>
#include <cstdio>
#include <cstdint>

#define LAS __attribute__((address_space(3)))
typedef unsigned short bf16_t;
typedef short bf16x8 __attribute__((ext_vector_type(8)));
typedef float f32x4 __attribute__((ext_vector_type(4)));
typedef float f32x2 __attribute__((ext_vector_type(2)));
typedef unsigned u32x4 __attribute__((ext_vector_type(4)));
typedef unsigned u32x2 __attribute__((ext_vector_type(2)));

constexpr int D = 1024, NBATCH = 4, SEQ = 4096, NCTX = 256, DEPTH = 4;
constexpr int RCTX = NBATCH * NCTX, RLAT = NBATCH * SEQ, RTOT = RCTX + RLAT;
constexpr int NE = 32, TOPK = 4, CAP = RTOT, MAXMT = 304;
constexpr int NTHR = 512, NWV = 8;
constexpr int LDS_BYTES = 157696, LDS_STAGE = 131072, LDS_MISC = 139264;

enum { I_X = 0, I_C, I_CTX, I_CCTX, I_ADAW, I_ADAB, I_N1G, I_N2G, I_FING, I_LRE, I_LIM, I_LDT, I_BRE, I_BIM, I_CRE, I_CIM, I_S5D, I_GLUW, I_GLUB,
       I_SCWIN, I_SCCW, I_SCWOUT, I_PW1W, I_PW1B, I_DWW, I_DWB, I_LNG, I_LNB, I_PW2W, I_PW2B, I_RW, I_RB, I_WGU, I_BGU, I_WD, I_BD, N_IN };

constexpr size_t MiB = 1u << 20;
constexpr size_t OFF_CTL = 0, CTL_BYTES = 1 * MiB;
constexpr size_t OFF_MOD = 1 * MiB, OFF_GATE = 2 * MiB, OFF_ELIST = 3 * MiB, OFF_BGUP = 6 * MiB, OFF_RWT = 7 * MiB;
constexpr size_t OFF_S5T = 7 * MiB + 512 * 1024;
constexpr size_t OFF_X = 8 * MiB, OFF_HN = 76 * MiB, OFF_A2 = 110 * MiB, OFF_F = 144 * MiB, OFF_Z = 178 * MiB;
constexpr size_t OFF_YF = 280 * MiB, OFF_YB = 348 * MiB, OFF_HM = 416 * MiB, OFF_Y = 568 * MiB;
constexpr size_t OFF_WT = 320 * MiB;
constexpr size_t OFF_KT = 280 * MiB, OFF_GT = 288 * MiB;
constexpr size_t OFF_WGLU = 704 * MiB, OFF_WSCIN = 712 * MiB, OFF_WSCOUT = 718 * MiB, OFF_WPW1 = 720 * MiB, OFF_WPW2 = 724 * MiB;
constexpr size_t OFF_WGU = 728 * MiB, OFF_WD = 1240 * MiB, WS_END = 1496 * MiB;
constexpr int CW_CNT = 64;
constexpr int CW_BAR = 4096;

struct P { const float* in[N_IN]; float* out; unsigned char* ws; };
typedef const __attribute__((address_space(4))) P* KP;
struct Cx { KP k; int wv; };
template <class T> __device__ __forceinline__ T* as_global(T* q) { return (T*)(__attribute__((address_space(1))) T*)q; }

#define WG_SYNC() do { __builtin_amdgcn_fence(__ATOMIC_RELEASE, "workgroup"); __builtin_amdgcn_s_barrier(); __builtin_amdgcn_fence(__ATOMIC_ACQUIRE, "workgroup"); } while (0)
typedef int i32x8 __attribute__((ext_vector_type(8)));
typedef int i32x4 __attribute__((ext_vector_type(4)));
__device__ __forceinline__ float sat8(float x) { return __builtin_fminf(__builtin_fmaxf(x, -448.f), 448.f); }
__device__ __forceinline__ unsigned pk4_fp8(float a, float b, float c, float d) { int r = 0; r = __builtin_amdgcn_cvt_pk_fp8_f32(a, b, r, false); r = __builtin_amdgcn_cvt_pk_fp8_f32(c, d, r, true); return (unsigned)r; }
__device__ __forceinline__ unsigned pk4_fp8_sat(float a, float b, float c, float d) { return pk4_fp8(sat8(a), sat8(b), sat8(c), sat8(d)); }
constexpr float W8_SCALE = 64.f, H8_SCALE = 4.f, Y8_SCALE = 16.f;
__device__ __forceinline__ int opaque_tid(int wv) { unsigned z = 0u; asm volatile("" : "+v"(z)); return wv * 64 + (int)__builtin_amdgcn_mbcnt_hi(~0u, __builtin_amdgcn_mbcnt_lo(~0u, z)); }
__device__ __forceinline__ float bf2f(unsigned b) { return __uint_as_float(b << 16); }
typedef __bf16 bf16x2_t __attribute__((ext_vector_type(2)));
__device__ __forceinline__ unsigned pk2(float lo, float hi) { const f32x2 v = {lo, hi}; return __builtin_bit_cast(unsigned, __builtin_convertvector(v, bf16x2_t)); }
__device__ __forceinline__ float sigm(float x) { return __builtin_amdgcn_rcpf(1.f + __expf(-x)); }
__device__ __forceinline__ float silu(float x) { return x * sigm(x); }
__device__ __forceinline__ float gelu_tanh(float x) { return x * sigm(1.5957691216f * (x + 0.044715f * x * x * x)); }
__device__ __forceinline__ float wave_sum(float v) {
#pragma unroll
    for (int o = 1; o < 64; o <<= 1) v += __shfl_xor(v, o);
    return v;
}
__device__ __forceinline__ int row_bi(int row) { return row < RCTX ? 4 : ((row - RCTX) >> 12); }
__device__ __forceinline__ void load_row(const float* r, int lane, f32x4 (&v)[4]) {
#pragma unroll
    for (int j = 0; j < 4; ++j) v[j] = *(const f32x4*)(r + 256 * j + 4 * lane);
}
__device__ __forceinline__ float row_sumsq(const f32x4 (&v)[4]) {
    float s = 0.f;
#pragma unroll
    for (int j = 0; j < 4; ++j) s += (v[j].x * v[j].x + v[j].y * v[j].y) + (v[j].z * v[j].z + v[j].w * v[j].w);
    return wave_sum(s);
}
__device__ __forceinline__ void norm_mod(const f32x4 (&v)[4], float rs, const float* g, const float* sc, const float* sh, int lane, f32x4 (&o)[4]) {
#pragma unroll
    for (int j = 0; j < 4; ++j) { const int col = 256 * j + 4 * lane;
        const f32x4 gg = *(const f32x4*)(g + col), s = *(const f32x4*)(sc + col), h = *(const f32x4*)(sh + col);
        o[j] = v[j] * rs * gg * (1.f + s) + h; }
}
__device__ __forceinline__ void store_row_bf16(bf16_t* dst, int lane, const f32x4 (&o)[4]) {
#pragma unroll
    for (int j = 0; j < 4; ++j) { u32x2 w; w.x = pk2(o[j].x, o[j].y); w.y = pk2(o[j].z, o[j].w); *(u32x2*)(dst + 256 * j + 4 * lane) = w; }
}
__device__ __forceinline__ void store_row_fp8(unsigned char* dst, int lane, const f32x4 (&o)[4]) {
#pragma unroll
    for (int j = 0; j < 4; ++j) *(unsigned*)(dst + 256 * j + 4 * lane) = pk4_fp8_sat(o[j].x, o[j].y, o[j].z, o[j].w);
}
__device__ __forceinline__ void store_row_s5(bf16_t* HNs, int row, int lane, const f32x4 (&o)[4]) {
    const int b = row < RCTX ? row >> 8 : (row - RCTX) >> 12, tok = row < RCTX ? row & 255 : NCTX + ((row - RCTX) & 4095);
#pragma unroll
    for (int j = 0; j < 4; ++j) { u32x2 w; w.x = pk2(o[j].x, o[j].y); w.y = pk2(o[j].z, o[j].w);
        *(u32x2*)(HNs + ((size_t)(b * 64 + 16 * j + (lane >> 2)) * (NCTX + SEQ) + tok) * 16 + (lane & 3) * 4) = w; }
}
__device__ __forceinline__ f32x4 ld_bf16x4(const bf16_t* p) { const u32x2 w = *(const u32x2*)p; return (f32x4){bf2f(w.x & 0xffffu), bf2f(w.x >> 16), bf2f(w.y & 0xffffu), bf2f(w.y >> 16)}; }
__device__ __forceinline__ void load_row_bf16(const bf16_t* r, int lane, f32x4 (&v)[4]) {
#pragma unroll
    for (int j = 0; j < 4; ++j) v[j] = ld_bf16x4(r + 256 * j + 4 * lane);
}


#define XB_TMO      128
#define XB_XCNT(j)  (256  + 64 * (j))
#define XB_XSUB(j)  (1280 + 64 * (j))
#define XB_XGEN(j)  (2304 + 64 * (j))
#define XB_TOP      3328
#define XB_TOPGEN   3392
#define XCD_BAR_WORDS 3456
#define XB_SPIN_CAP (1u << 18)

typedef __attribute__((address_space(1))) unsigned gu32;
__device__ __forceinline__ unsigned xb_ld(unsigned* p)              { return __hip_atomic_load((gu32*)p, __ATOMIC_RELAXED, __HIP_MEMORY_SCOPE_AGENT); }
__device__ __forceinline__ unsigned xb_add(unsigned* p, unsigned v) { return __hip_atomic_fetch_add((gu32*)p, v, __ATOMIC_RELAXED, __HIP_MEMORY_SCOPE_AGENT); }
__device__ __forceinline__ unsigned xb_xcc_id() { return (unsigned)__builtin_amdgcn_s_getreg((3 << 11) | 20) & 0xFu; }
#define XB_SPIN(cond, bar) do { unsigned _sp = 0; while (cond) { __builtin_amdgcn_s_sleep(1); \
    if ((++_sp & 255u) == 0u) { if (xb_ld(&(bar)[XB_TMO])) break; if (_sp > XB_SPIN_CAP) { xb_add(&(bar)[XB_TMO], 1u); break; } } } } while (0)

struct XcdBarrier {
    unsigned* bar; unsigned x;
    volatile LAS unsigned* st;
};
__device__ __forceinline__ XcdBarrier xcd_barrier_post(unsigned* bar, volatile LAS unsigned* st) {
    XcdBarrier b; b.bar = bar; b.x = xb_xcc_id(); b.st = st;
    if (threadIdx.x == 0) (void)xb_add(&as_global(bar)[XB_XCNT(b.x)], 1u);
    return b;
}
__device__ __forceinline__ void xcd_barrier_complete(unsigned* bar, unsigned x, unsigned& nloc, unsigned& nx) {
    const unsigned G = gridDim.x * gridDim.y * gridDim.z;
    unsigned sum, cnt, mine, sp = 0u;
    for (;;) {
        sum = 0u; cnt = 0u; mine = 0u;
#pragma unroll
        for (unsigned j = 0; j < 16; ++j) { const unsigned c = xb_ld(&bar[XB_XCNT(j)]); sum += c; cnt += (c > 0u) ? 1u : 0u; mine = (j == x) ? c : mine; }
        if (sum == G) break;
        __builtin_amdgcn_s_sleep(1);
        if ((++sp & 255u) == 0u) { if (xb_ld(&bar[XB_TMO])) break; if (sp > XB_SPIN_CAP) { xb_add(&bar[XB_TMO], 1u); break; } }
    }
    nloc = mine > 0u ? mine : 1u; nx = cnt > 0u ? cnt : 1u;
}
__device__ __forceinline__ void xcd_barrier(const XcdBarrier& b, int wv) {
    asm volatile("s_waitcnt vmcnt(0)" ::: "memory");
    WG_SYNC();
    if (opaque_tid(wv) == 0) {
        unsigned* bar = b.bar; asm volatile("" : "+s"(bar)); bar = as_global(bar);
        __builtin_amdgcn_s_waitcnt(0);
        unsigned nloc = b.st[0], nx = b.st[1];
        if (nloc == 0u) { xcd_barrier_complete(bar, b.x, nloc, nx); b.st[0] = nloc; b.st[1] = nx; }
        const unsigned old = xb_add(&bar[XB_XSUB(b.x)], 1u);
        const unsigned gen = old / nloc;
        if (old + 1u == (gen + 1u) * nloc) {
            __builtin_amdgcn_fence(__ATOMIC_RELEASE, "agent");
            asm volatile("s_waitcnt vmcnt(0)" ::: "memory");
            const unsigned og = xb_add(&bar[XB_TOP], 1u);
            const unsigned tg = og / nx;
            if (og + 1u == (tg + 1u) * nx) xb_add(&bar[XB_TOPGEN], 1u);
            else XB_SPIN(xb_ld(&bar[XB_TOPGEN]) == tg, bar);
            __builtin_amdgcn_fence(__ATOMIC_ACQUIRE, "agent");
            xb_add(&bar[XB_XGEN(b.x)], 1u);
            asm volatile("s_waitcnt vmcnt(0)" ::: "memory");
        } else {
            XB_SPIN(xb_ld(&bar[XB_XGEN(b.x)]) == gen, bar);
            __builtin_amdgcn_fence(__ATOMIC_ACQUIRE, "agent");
            asm volatile("s_waitcnt vmcnt(0)" ::: "memory");
        }
    }
    WG_SYNC();
}

__device__ __forceinline__ int tr_dst(int mode, int cb, int n) {
    if (mode == 0) return cb * 64 + n;
    if (mode == 3) {
        if (cb < 16) return 256 * (cb >> 1) + 64 * (cb & 1) + n;
        if (cb < 32) return 2048 + 64 * (cb - 16) + n;
        return 256 * ((cb - 32) >> 1) + 128 + 64 * (cb & 1) + n; }
    const int j0 = cb * 32, pn = j0 >> 7, jo = j0 & 127;
    if (mode == 1) return 256 * pn + 128 * (n >> 5) + jo + (n & 31);
    return 256 * pn + 128 * (n & 1) + jo + (n >> 1);
}
__device__ __forceinline__ int tr_src(int mode, int cb, int n, int N) {
    if (mode == 0) return cb * 64 + n;
    if (mode == 1) return (n >> 5) * (N >> 1) + cb * 32 + (n & 31);
    return cb * 64 + n;
}
__device__ __forceinline__ void tr_item(const float* W, int N, bf16_t* WT, int mode, int kb, int cb, LAS float* scr, int lane) {
    const int k0 = kb * 64; const int src = tr_src(mode, cb, lane, N);
#pragma unroll 16
    for (int kk = 0; kk < 64; ++kk) scr[kk * 65 + lane] = __builtin_nontemporal_load(W + (size_t)(k0 + kk) * N + src);
    asm volatile("s_waitcnt lgkmcnt(0)" ::: "memory");
    const int c = lane & 7;
#pragma unroll
    for (int j = 0; j < 8; ++j) { const int n = (lane >> 3) + 8 * j; const LAS float* s = scr + (8 * c) * 65 + n;
        u32x4 o; o.x = pk2(s[0], s[65]); o.y = pk2(s[2 * 65], s[3 * 65]); o.z = pk2(s[4 * 65], s[5 * 65]); o.w = pk2(s[6 * 65], s[7 * 65]);
        *(u32x4*)(WT + (size_t)tr_dst(mode, cb, n) * 1024 + k0 + 8 * c) = o; }
    asm volatile("s_waitcnt lgkmcnt(0)" ::: "memory");
}
__device__ __forceinline__ void tr_item8(const float* W, int N, unsigned char* WT, int mode, int kb, int cb, LAS float* scr, int lane) {
    const int k0 = kb * 64; const int src = tr_src(mode, cb, lane, N);
#pragma unroll 16
    for (int kk = 0; kk < 64; ++kk) scr[kk * 65 + lane] = __builtin_nontemporal_load(W + (size_t)(k0 + kk) * N + src);
    asm volatile("s_waitcnt lgkmcnt(0)" ::: "memory");
    const int c = lane & 3;
#pragma unroll
    for (int j = 0; j < 4; ++j) { const int n = (lane >> 2) + 16 * j; const LAS float* s = scr + (16 * c) * 65 + n;
        u32x4 o;
        o.x = pk4_fp8(s[0] * W8_SCALE, s[65] * W8_SCALE, s[2 * 65] * W8_SCALE, s[3 * 65] * W8_SCALE); o.y = pk4_fp8(s[4 * 65] * W8_SCALE, s[5 * 65] * W8_SCALE, s[6 * 65] * W8_SCALE, s[7 * 65] * W8_SCALE);
        o.z = pk4_fp8(s[8 * 65] * W8_SCALE, s[9 * 65] * W8_SCALE, s[10 * 65] * W8_SCALE, s[11 * 65] * W8_SCALE); o.w = pk4_fp8(s[12 * 65] * W8_SCALE, s[13 * 65] * W8_SCALE, s[14 * 65] * W8_SCALE, s[15 * 65] * W8_SCALE);
        *(u32x4*)(WT + (size_t)tr_dst(mode, cb, n) * 1024 + k0 + 16 * c) = o; }
    asm volatile("s_waitcnt lgkmcnt(0)" ::: "memory");
}
constexpr int MOE_ITEMS_GU = NE * 16 * 32, MOE_ITEMS = MOE_ITEMS_GU + NE * 16 * 16;
__device__ __forceinline__ void conv_moe_item(const Cx& p, int l, int I, LAS float* scr, int lane) {
    if (I < MOE_ITEMS_GU) { const int e = I >> 9, rr = I & 511, kb = rr >> 5, cb = rr & 31;
        tr_item8(as_global(p.k->in[I_WGU]) + (size_t)(l * NE + e) * 1024 * 2048, 2048, as_global(p.k->ws) + OFF_WGU + (size_t)(l * NE + e) * 2 * MiB, 2, kb, cb, scr, lane); }
    else { const int J = I - MOE_ITEMS_GU, e = J >> 8, rr = J & 255, kb = rr >> 4, cb = rr & 15;
        tr_item8(as_global(p.k->in[I_WD]) + (size_t)(l * NE + e) * 1024 * 1024, 1024, as_global(p.k->ws) + OFF_WD + (size_t)(l * NE + e) * 1 * MiB, 0, kb, cb, scr, lane); }
}
constexpr int TAIL_Q = 3;
__device__ __forceinline__ int tail_cap(int total, int G) { const int rounds = (total + G - 1) / G, rem = total - (rounds - 1) * G; return rem == G ? 0 : (G - rem) * NWV * TAIL_Q; }
__device__ __forceinline__ void tail_convert(const Cx& p, LAS unsigned char* lds, int lnext, int base, int total) {
    const int G = gridDim.x, c = blockIdx.x, rounds = (total + G - 1) / G, rem = total - (rounds - 1) * G;
    if (rem == G || c < rem) return;
    const int tid = opaque_tid(p.wv), lane = tid & 63, wave = p.wv; LAS float* scr = (LAS float*)(lds + wave * 16640);
    const int i0 = base + ((c - rem) * NWV + wave) * TAIL_Q;
#pragma unroll 1
    for (int k = 0; k < TAIL_Q; ++k) if (i0 + k < MOE_ITEMS) conv_moe_item(p, lnext, i0 + k, scr, lane);
}
__device__ __forceinline__ void conv_catchup(const Cx& p, LAS unsigned char* lds, int l, int covered) {
    const int tid = opaque_tid(p.wv), lane = tid & 63, wave = p.wv; LAS float* scr = (LAS float*)(lds + wave * 16640);
    for (int I = covered + blockIdx.x * NWV + wave; I < MOE_ITEMS; I += gridDim.x * NWV) conv_moe_item(p, l, I, scr, lane);
    WG_SYNC();
}
__device__ __forceinline__ void ph_prep(const Cx& p, LAS unsigned char* lds) {
    const int tid = opaque_tid(p.wv), lane = tid & 63, wave = tid >> 6;
    LAS float* scr = (LAS float*)(lds + wave * 16640);
    const int gw = blockIdx.x * NWV + wave, NGW = gridDim.x * NWV;
    constexpr int NJ = 7;
    const int jsrc[NJ] = {I_WGU, I_WD, I_GLUW, I_SCWIN, I_SCWOUT, I_PW1W, I_PW2W};
    const int jN[NJ] = {2048, 1024, 2048, 3072, 1024, 2048, 1024};
    const int jmode[NJ] = {2, 0, 1, 3, 0, 1, 0};
    const int jnmat[NJ] = {128, 128, 2, 1, 1, 1, 1};
    const size_t joff[NJ] = {OFF_WGU, OFF_WD, OFF_WGLU, OFF_WSCIN, OFF_WSCOUT, OFF_WPW1, OFF_WPW2};
    { LAS float* pw = (LAS float*)lds;
      LAS float* ql = pw + 4224; LAS float* cl = pw + 4352; LAS float* bl = pw + 6400;
      for (int item = blockIdx.x; item < 2 * 2 * 64; item += gridDim.x) {
          const int jd = item >> 6, g = item & 63, jj = jd >> 1, d = jd & 1;
          WG_SYNC();
          { const int n = tid & 63, eg = tid >> 6, i = (jd * 64 + g) * 64 + n; const float lre = as_global(p.k->in[I_LRE])[i], lim = as_global(p.k->in[I_LIM])[i], dt = __expf(as_global(p.k->in[I_LDT])[i >> 6]);
#pragma unroll 1
            for (int e = eg; e <= 32; e += 8) { const float er = expf(lre * dt * (float)e), ang = lim * dt * (float)e; pw[(e * 64 + n) * 2] = er * cosf(ang); pw[(e * 64 + n) * 2 + 1] = er * sinf(ang); }
            if (eg == 1) { const float er = expf(lre * dt), nr = er * cosf(lim * dt) - 1.f, ni = er * sinf(lim * dt), den = 1.f / (lre * lre + lim * lim);
                ql[n * 2] = (nr * lre + ni * lim) * den; ql[n * 2 + 1] = (ni * lre - nr * lim) * den; }
            const size_t cb0 = (size_t)(jd * 64 + g) * 1024;
#pragma unroll
            for (int q = 0; q < 2; ++q) { const int idx = tid + NTHR * q; cl[idx * 2] = as_global(p.k->in[I_CRE])[cb0 + idx]; cl[idx * 2 + 1] = as_global(p.k->in[I_CIM])[cb0 + idx];
                bl[idx * 2] = as_global(p.k->in[I_BRE])[cb0 + idx]; bl[idx * 2 + 1] = as_global(p.k->in[I_BIM])[cb0 + idx]; } }
          WG_SYNC();
          { const int pair = tid & 255, hq = pair >> 4, hp = pair & 15, lh = tid >> 8;
            unsigned short* kt = (unsigned short*)(as_global(p.k->ws) + OFF_KT + (size_t)((jj * 64 + g) * 2 + d) * 16896);
            float sacc[16];
#pragma unroll
            for (int q = 0; q < 16; ++q) sacc[q] = 0.f;
            if (lh == 0) kt[pair] = 0;
#pragma unroll 2
            for (int n = 0; n < 64; ++n) { const float qr = ql[n * 2], qi = ql[n * 2 + 1], br = bl[(n * 16 + hp) * 2], bi = bl[(n * 16 + hp) * 2 + 1], cr = cl[(hq * 64 + n) * 2], ci = cl[(hq * 64 + n) * 2 + 1];
                const float bbr = qr * br - qi * bi, bbi = qr * bi + qi * br, cbr = cr * bbr - ci * bbi, cbi = cr * bbi + ci * bbr;
#pragma unroll
                for (int q = 0; q < 16; ++q) { const int lg = 16 * lh + q; sacc[q] += cbr * pw[(lg * 64 + n) * 2] - cbi * pw[(lg * 64 + n) * 2 + 1]; } }
#pragma unroll
            for (int q = 0; q < 16; ++q) kt[(16 * lh + q + 1) * 256 + pair] = (unsigned short)(pk2(sacc[q], 0.f) & 0xffffu); }
          { const int t = tid >> 4, hq = tid & 15, e = d == 0 ? t + 1 : 32 - t, m = t >> 1, ii = (t & 1) * 16 + hq;
            unsigned char* gt = as_global(p.k->ws) + OFF_GT + (size_t)((jj * 64 + g) * 2 + d) * 131072;
#pragma unroll 4
            for (int n = 0; n < 64; ++n) { const float pr = pw[(e * 64 + n) * 2], pi = pw[(e * 64 + n) * 2 + 1], cr = cl[(hq * 64 + n) * 2], ci = cl[(hq * 64 + n) * 2 + 1];
                *(unsigned*)(gt + ((m * 8 + (n >> 3)) * 64 + ((n >> 2) & 1) * 32 + ii) * 16 + (n & 3) * 4) = pk2(cr * pr - ci * pi, -(cr * pi + ci * pr)); } }
          { const int ig = tid & 127, mt = ig >> 5, ii = ig & 31, st = 16 * mt + (ii >> 1), ri = ii & 1, hf = (tid >> 7) & 1, sg = tid >> 8;
            unsigned char* wt = as_global(p.k->ws) + OFF_WT + (size_t)((jj * 64 + g) * 2 + d) * 131072;
            const float qr = ql[st * 2], qi = ql[st * 2 + 1]; float bbr[8], bbi[8];
#pragma unroll
            for (int c = 0; c < 8; ++c) { const float br = bl[(st * 16 + 8 * hf + c) * 2], bi = bl[(st * 16 + 8 * hf + c) * 2 + 1]; bbr[c] = qr * br - qi * bi; bbi[c] = qr * bi + qi * br; }
#pragma unroll 2
            for (int s = 16 * sg; s < 16 * sg + 16; ++s) { const int e = d == 0 ? 31 - s : s; const float pr = pw[(e * 64 + st) * 2], pi = pw[(e * 64 + st) * 2 + 1]; float v[8];
#pragma unroll
                for (int c = 0; c < 8; ++c) v[c] = ri ? pr * bbi[c] + pi * bbr[c] : pr * bbr[c] - pi * bbi[c];
                u32x4 o; o.x = pk2(v[0], v[1]); o.y = pk2(v[2], v[3]); o.z = pk2(v[4], v[5]); o.w = pk2(v[6], v[7]);
                *(u32x4*)(wt + ((mt * 32 + s) * 64 + hf * 32 + ii) * 16) = o; } }
      }
      WG_SYNC(); }
    int base = 0;
#pragma unroll
    for (int j = 2; j < NJ; ++j) {
        const int N = jN[j], ncb = N / 64, ipm = 16 * ncb, tot = ipm * jnmat[j];
        const float* W0 = as_global(p.k->in[jsrc[j]]); bf16_t* T0 = (bf16_t*)(as_global(p.k->ws) + joff[j]);
        int first = gw - (base % NGW); if (first < 0) first += NGW;
        for (int it = first; it < tot; it += NGW) { const int mat = it / ipm, rr = it % ipm, kb = rr / ncb, cb = rr % ncb;
            if (j != 3) tr_item8(W0 + (size_t)mat * 1024 * N, N, (unsigned char*)T0 + (size_t)mat * N * 1024, jmode[j], kb, cb, scr, lane);
            else tr_item(W0 + (size_t)mat * 1024 * N, N, T0 + (size_t)mat * N * 1024, jmode[j], kb, cb, scr, lane); }
        base += tot;
    }
    { int first = gw - (base % NGW); if (first < 0) first += NGW;
      for (int I = first; I < MOE_ITEMS; I += NGW) conv_moe_item(p, 0, I, scr, lane); }
    { f32x4* tb = (f32x4*)(as_global(p.k->ws) + OFF_S5T);
      for (int i = blockIdx.x * NTHR + tid; i < 4 * 64 * 64; i += gridDim.x * NTHR) {
          const float lre = as_global(p.k->in[I_LRE])[i], lim = as_global(p.k->in[I_LIM])[i], dt = __expf(as_global(p.k->in[I_LDT])[i >> 6]);
          const float er = expf(lre * dt), lbr = er * cosf(lim * dt), lbi = er * sinf(lim * dt);
          const float nr = lbr - 1.f, ni = lbi, den = 1.f / (lre * lre + lim * lim);
          tb[i] = (f32x4){lbr, lbi, (nr * lre + ni * lim) * den, (ni * lre - nr * lim) * den}; } }
    { const float* rw = as_global(p.k->in[I_RW]); bf16_t* rt = (bf16_t*)(as_global(p.k->ws) + OFF_RWT);
      for (int i = blockIdx.x * NTHR + tid; i < DEPTH * NE * D; i += gridDim.x * NTHR) { const int k = i & 1023, e = (i >> 10) & 31, l = i >> 15;
          rt[i] = (bf16_t)(pk2(rw[((size_t)l * D + k) * NE + e], 0.f) & 0xffffu); } }
    { const float* bgu = as_global(p.k->in[I_BGU]); float* bp = (float*)(as_global(p.k->ws) + OFF_BGUP);
      for (int i = blockIdx.x * NTHR + tid; i < DEPTH * NE * 2048; i += gridDim.x * NTHR) {
          const int n = i & 2047, m = i >> 11, pn = n >> 8, s = (n >> 7) & 1, jj = n & 127;
          bp[i] = bgu[(size_t)m * 2048 + 2 * (128 * pn + jj) + s]; } }
}
__device__ __forceinline__ void ph_mod(const Cx& p, LAS unsigned char* lds) {
    const int tid = opaque_tid(p.wv), lane = tid & 63, wave = tid >> 6;
    LAS float* sc = (LAS float*)lds; LAS float* red = sc + 5 * 1024;
    for (int i = tid; i < 5 * 1024; i += NTHR) { const int bi = i >> 10, k = i & 1023; const float v = bi < 4 ? as_global(p.k->in[I_C])[bi * 1024 + k] : as_global(p.k->in[I_CCTX])[k]; sc[i] = silu(v); }
    WG_SYNC();
    float* mod = (float*)(as_global(p.k->ws) + OFF_MOD);
    for (int item = blockIdx.x; item < DEPTH * 48; item += gridDim.x) {
        const int l = item / 48, n0 = (item % 48) * 128;
        const float* W = as_global(p.k->in[I_ADAW]) + (size_t)l * 1024 * 6144 + n0 + lane * 2;
        float a[5][2];
#pragma unroll
        for (int b = 0; b < 5; ++b) { a[b][0] = 0.f; a[b][1] = 0.f; }
#pragma unroll 16
        for (int k = wave * 128; k < wave * 128 + 128; ++k) { const f32x2 w = __builtin_nontemporal_load((const f32x2*)(W + (size_t)k * 6144));
#pragma unroll
            for (int b = 0; b < 5; ++b) { const float s = sc[b * 1024 + k]; a[b][0] += s * w.x; a[b][1] += s * w.y; } }
#pragma unroll
        for (int b = 0; b < 5; ++b) { red[(wave * 5 + b) * 128 + lane * 2] = a[b][0]; red[(wave * 5 + b) * 128 + lane * 2 + 1] = a[b][1]; }
        WG_SYNC();
        for (int o = tid; o < 640; o += NTHR) { const int b = o >> 7, col = o & 127; float s = as_global(p.k->in[I_ADAB])[l * 6144 + n0 + col];
#pragma unroll
            for (int w = 0; w < 8; ++w) s += red[(w * 5 + b) * 128 + col];
            mod[(size_t)(l * 5 + b) * 6144 + n0 + col] = s; }
        WG_SYNC();
    }
}
__device__ __forceinline__ void ph_norm_first(const Cx& p) {
    const int tid = opaque_tid(p.wv), lane = tid & 63, wave = tid >> 6;
    bf16_t* X = (bf16_t*)(as_global(p.k->ws) + OFF_X); bf16_t* HN = (bf16_t*)(as_global(p.k->ws) + OFF_HN); const float* mod = (const float*)(as_global(p.k->ws) + OFF_MOD);
    for (int row = blockIdx.x * NWV + wave; row < RTOT; row += gridDim.x * NWV) {
        const float* src = row < RCTX ? as_global(p.k->in[I_CTX]) + (size_t)row * D : as_global(p.k->in[I_X]) + (size_t)(row - RCTX) * D;
        f32x4 v[4], o[4];
#pragma unroll
        for (int j = 0; j < 4; ++j) v[j] = __builtin_nontemporal_load((const f32x4*)(src + 256 * j + 4 * lane));
        store_row_bf16(X + (size_t)row * D, lane, v);
        const float rs = rsqrtf(row_sumsq(v) * (1.f / D) + 1e-6f);
        const float* m = mod + (size_t)(0 * 5 + row_bi(row)) * 6144;
        norm_mod(v, rs, as_global(p.k->in[I_N1G]), m + 1024, m, lane, o);
        store_row_s5(HN, row, lane, o);
    }
}

namespace g8 {
constexpr int BM = 256, BK = 64, HALF = 128, HTB = HALF * BK * 2;
__host__ __device__ __forceinline__ int lds_byte(int r, int c) { const int st = (r >> 4) * 2 + (c >> 5), rr = r & 15, cc = c & 31, ob = rr * 64 + cc * 2; return st * 1024 + (ob ^ (((ob >> 9) & 1) << 5)); }
__host__ __device__ __forceinline__ void stage_rc(int b, int& R, int& C) { const int st = b / 1024, sb = b % 1024, swz = sb ^ (((sb >> 9) & 1) << 5); R = (st >> 1) * 16 + swz / 64; C = (st & 1) * 32 + (swz % 64) / 2; }
__host__ __device__ __forceinline__ int perm32(int rho) { const int n = rho >> 4, i = rho & 15; return 8 * (i >> 2) + 4 * n + (i & 3); }

struct Unit { const char* B; int row0, pn, e, nvalid, lbase, bi, ui, rot; };
constexpr int MOE_TAB_UNITS = 14, MOE_MAX_UNITS = 16;
__device__ __forceinline__ KP fresh(KP k) { asm volatile("" : "+s"(k)); return k; }

template <int RB> struct SchedDenseT {
    KP k; size_t woff; int row_lo, nM, nN, G, c;
    __device__ __forceinline__ bool next(int i, Unit& u) const {
        const int L = i * G + c; if (L >= nM * nN) return false;
        const int pm = L / nN, pn = L % nN;
        u.B = (const char*)(as_global(fresh(k)->ws) + woff) + (size_t)pn * 256 * RB; u.row0 = row_lo + pm * 256; u.pn = pn; u.e = 0; u.nvalid = 256; u.lbase = 0; u.bi = row_bi(u.row0); u.ui = i; u.rot = 0; return true;
    }
    __device__ __forceinline__ unsigned aoff(const Unit& u, int, int r, int C) const { return (unsigned)(u.row0 + r) * (unsigned)RB + (unsigned)C * 2u; }
    static constexpr int ROWB = RB;
};
typedef SchedDenseT<2048> SchedDense;
typedef SchedDenseT<1024> SchedDense8;
struct SchedMoe {
    KP k; size_t woff, estride; const LAS int* desc; const LAS int* tab; int nu; bool gather;
    __device__ __forceinline__ bool next(int i, Unit& u) const {
        if (i >= nu) return false;
        const int e = __builtin_amdgcn_readfirstlane(desc[4 * i]), mg = __builtin_amdgcn_readfirstlane(desc[4 * i + 1]), nv = __builtin_amdgcn_readfirstlane(desc[4 * i + 2]), pr = __builtin_amdgcn_readfirstlane(desc[4 * i + 3]), pn = pr & 0xff;
        u.rot = pr >> 8; u.B = (const char*)(as_global(fresh(k)->ws) + woff) + (size_t)e * estride + (size_t)pn * 256 * ROWB; u.row0 = mg * 256; u.pn = pn; u.e = e; u.nvalid = nv & 0xffff; u.lbase = e * CAP + (nv >> 16) * 256; u.bi = 0; u.ui = i; return true;
    }
    __device__ __forceinline__ unsigned aoff(const Unit& u, int ui, int r, int C) const {
        if (gather) return (unsigned)tab[ui * 256 + r] + (unsigned)C * 2u;
        return (unsigned)(u.row0 + r) * (unsigned)ROWB + (unsigned)C * 2u;
    }
    static constexpr int ROWB = 1024;
};

struct EpiGluRes {
    static constexpr int PERM = 1;
    KP k; int l;
    __device__ __forceinline__ void operator()(const f32x4 (&acc)[2][2][4][2], const Unit& u, int wr, int wc, int fr, int fq) const {
        const KP kk = fresh(k); bf16_t* X = (bf16_t*)(as_global(kk->ws) + OFF_X); const float* bias = as_global(kk->in[I_GLUB]) + (l / 3) * 2048;
        const int j0 = u.pn * 128 + wc * 32 + 8 * fq; const float* g1 = (const float*)(as_global(kk->ws) + OFF_MOD) + (size_t)(l * 5 + u.bi) * 6144 + 2048;
        f32x4 ba[2], bg[2], gg[2];
#pragma unroll
        for (int n = 0; n < 2; ++n) { ba[n] = *(const f32x4*)(bias + j0 + 4 * n); bg[n] = *(const f32x4*)(bias + 1024 + j0 + 4 * n); gg[n] = *(const f32x4*)(g1 + j0 + 4 * n); }
#pragma unroll
        for (int ai = 0; ai < 2; ++ai)
#pragma unroll
            for (int m = 0; m < 4; ++m) { bf16_t* xp = X + (size_t)(u.row0 + ai * 128 + wr * 64 + m * 16 + fr) * D + j0;
                const u32x4 xw = *(const u32x4*)xp; const unsigned xs[4] = {xw.x, xw.y, xw.z, xw.w}; unsigned os[4];
#pragma unroll
                for (int n = 0; n < 2; ++n) { const f32x4 a = acc[ai][0][m][n] * (1.f / W8_SCALE) + ba[n], g = acc[ai][1][m][n] * (1.f / W8_SCALE) + bg[n];
                    f32x4 x = (f32x4){bf2f(xs[2 * n] & 0xffffu), bf2f(xs[2 * n] >> 16), bf2f(xs[2 * n + 1] & 0xffffu), bf2f(xs[2 * n + 1] >> 16)};
                    x.x += gg[n].x * a.x * sigm(g.x); x.y += gg[n].y * a.y * sigm(g.y); x.z += gg[n].z * a.z * sigm(g.z); x.w += gg[n].w * a.w * sigm(g.w);
                    os[2 * n] = pk2(x.x, x.y); os[2 * n + 1] = pk2(x.z, x.w); }
                *(u32x4*)xp = (u32x4){os[0], os[1], os[2], os[3]}; }
    }
};
struct EpiRes {
    static constexpr int PERM = 1;
    KP k; int l, bias_idx;
    __device__ __forceinline__ void operator()(const f32x4 (&acc)[2][2][4][2], const Unit& u, int wr, int wc, int fr, int fq) const {
        const KP kk = fresh(k); bf16_t* X = (bf16_t*)(as_global(kk->ws) + OFF_X); const float* bias = bias_idx >= 0 ? as_global(kk->in[bias_idx]) : nullptr;
        const int c0 = u.pn * 256 + wc * 32 + 8 * fq; const float* g1 = (const float*)(as_global(kk->ws) + OFF_MOD) + (size_t)(l * 5 + u.bi) * 6144 + 2048;
        f32x4 bv[2][2], gg[2][2];
#pragma unroll
        for (int bj = 0; bj < 2; ++bj)
#pragma unroll
            for (int n = 0; n < 2; ++n) { const int c = c0 + 128 * bj + 4 * n; bv[bj][n] = bias ? *(const f32x4*)(bias + c) : (f32x4){0.f, 0.f, 0.f, 0.f}; gg[bj][n] = *(const f32x4*)(g1 + c); }
#pragma unroll
        for (int ai = 0; ai < 2; ++ai)
#pragma unroll
            for (int m = 0; m < 4; ++m) { bf16_t* xp = X + (size_t)(u.row0 + ai * 128 + wr * 64 + m * 16 + fr) * D + c0;
#pragma unroll
                for (int bj = 0; bj < 2; ++bj) { const u32x4 xw = *(const u32x4*)(xp + 128 * bj); const unsigned xs[4] = {xw.x, xw.y, xw.z, xw.w}; unsigned os[4];
#pragma unroll
                    for (int n = 0; n < 2; ++n) { f32x4 x = (f32x4){bf2f(xs[2 * n] & 0xffffu), bf2f(xs[2 * n] >> 16), bf2f(xs[2 * n + 1] & 0xffffu), bf2f(xs[2 * n + 1] >> 16)};
                        x += gg[bj][n] * (acc[ai][bj][m][n] * (1.f / W8_SCALE) + bv[bj][n]); os[2 * n] = pk2(x.x, x.y); os[2 * n + 1] = pk2(x.z, x.w); }
                    *(u32x4*)(xp + 128 * bj) = (u32x4){os[0], os[1], os[2], os[3]}; } }
    }
};
struct EpiBf16 {
    static constexpr int PERM = 1;
    KP k; size_t ooff; int ldc; float dq;
    __device__ __forceinline__ void operator()(const f32x4 (&acc)[2][2][4][2], const Unit& u, int wr, int wc, int fr, int fq) const {
        bf16_t* O = (bf16_t*)(as_global(fresh(k)->ws) + ooff);
        const int c0 = u.pn * 256 + wc * 32 + 8 * fq;
#pragma unroll
        for (int ai = 0; ai < 2; ++ai)
#pragma unroll
            for (int m = 0; m < 4; ++m) { bf16_t* op = O + (size_t)(u.row0 + ai * 128 + wr * 64 + m * 16 + fr) * ldc + c0;
#pragma unroll
                for (int bj = 0; bj < 2; ++bj) { const f32x4 v0 = acc[ai][bj][m][0] * dq, v1 = acc[ai][bj][m][1] * dq;
                    u32x4 w; w.x = pk2(v0.x, v0.y); w.y = pk2(v0.z, v0.w); w.z = pk2(v1.x, v1.y); w.w = pk2(v1.z, v1.w); *(u32x4*)(op + 128 * bj) = w; } }
    }
};
struct EpiScin {
    static constexpr int PERM = 1;
    KP k;
    __device__ __forceinline__ void operator()(const f32x4 (&acc)[2][2][4][2], const Unit& u, int wr, int wc, int fr, int fq) const {
        bf16_t* O = (bf16_t*)(as_global(fresh(k)->ws) + OFF_Z);
        if (u.pn < 8) { const int j0 = u.pn * 128 + wc * 32 + 8 * fq;
#pragma unroll
            for (int ai = 0; ai < 2; ++ai)
#pragma unroll
                for (int m = 0; m < 4; ++m) { const f32x4 p0 = acc[ai][0][m][0] * acc[ai][1][m][0], p1 = acc[ai][0][m][1] * acc[ai][1][m][1];
                    u32x4 w; w.x = pk2(p0.x, p0.y); w.y = pk2(p0.z, p0.w); w.z = pk2(p1.x, p1.y); w.w = pk2(p1.z, p1.w);
                    *(u32x4*)(O + (size_t)(u.row0 + ai * 128 + wr * 64 + m * 16 + fr) * 2048 + j0) = w; }
        } else { const int c0 = 1024 + (u.pn - 8) * 256 + wc * 32 + 8 * fq;
#pragma unroll
            for (int ai = 0; ai < 2; ++ai)
#pragma unroll
                for (int m = 0; m < 4; ++m) { bf16_t* op = O + (size_t)(u.row0 + ai * 128 + wr * 64 + m * 16 + fr) * 2048 + c0;
#pragma unroll
                    for (int bj = 0; bj < 2; ++bj) { const f32x4 v0 = acc[ai][bj][m][0], v1 = acc[ai][bj][m][1];
                        u32x4 w; w.x = pk2(v0.x, v0.y); w.y = pk2(v0.z, v0.w); w.z = pk2(v1.x, v1.y); w.w = pk2(v1.z, v1.w); *(u32x4*)(op + 128 * bj) = w; } }
        }
    }
};
template <int ACT> struct EpiPairBf16 {
    static constexpr int PERM = 1;
    KP k; int l;
    __device__ __forceinline__ void operator()(const f32x4 (&acc)[2][2][4][2], const Unit& u, int wr, int wc, int fr, int fq) const {
        const KP kk = fresh(k);
        unsigned char* Ob = as_global(kk->ws) + (ACT == 0 ? OFF_Z : OFF_HM);
        const float* bb = ACT == 0 ? as_global(kk->in[I_PW1B]) : (const float*)(as_global(kk->ws) + OFF_BGUP) + (size_t)(l * NE + u.e) * 2048;
        const int j0 = u.pn * 128 + wc * 32 + 8 * fq;
        f32x4 ba[2], bg[2];
#pragma unroll
        for (int n = 0; n < 2; ++n) {
            if (ACT == 0) { ba[n] = *(const f32x4*)(bb + j0 + 4 * n); bg[n] = *(const f32x4*)(bb + 1024 + j0 + 4 * n); }
            else { const int q = u.pn * 256 + wc * 32 + 8 * fq + 4 * n; ba[n] = *(const f32x4*)(bb + q); bg[n] = *(const f32x4*)(bb + 128 + q); } }
#pragma unroll
        for (int ai = 0; ai < 2; ++ai)
#pragma unroll
            for (int m = 0; m < 4; ++m) { const size_t orow = (size_t)(u.row0 + ai * 128 + wr * 64 + m * 16 + fr);
                float r[8];
#pragma unroll
                for (int n = 0; n < 2; ++n) { const float dq = 1.f / W8_SCALE; const f32x4 a = acc[ai][0][m][n] * dq + ba[n], g = acc[ai][1][m][n] * dq + bg[n];
#pragma unroll
                    for (int q = 0; q < 4; ++q) {
                        if (ACT == 0) r[4 * n + q] = a[q] * sigm(g[q]);
                        else { const float gt = fminf(a[q], 7.0f), up = fminf(fmaxf(g[q], -7.0f), 7.0f);
                            const float rc = __builtin_amdgcn_rcpf(1.f + __builtin_amdgcn_exp2f(gt * (-1.702f * 1.44269504088896f))); r[4 * n + q] = (gt * rc) * __builtin_fmaf(up, H8_SCALE, H8_SCALE); } } }
                if (ACT == 0) { u32x4 w; w.x = pk2(r[0], r[1]); w.y = pk2(r[2], r[3]); w.z = pk2(r[4], r[5]); w.w = pk2(r[6], r[7]); *(u32x4*)(Ob + orow * 2048 + j0 * 2) = w; }
                else { u32x2 w; w.x = pk4_fp8(r[0], r[1], r[2], r[3]); w.y = pk4_fp8(r[4], r[5], r[6], r[7]); *(u32x2*)(Ob + orow * 1024 + j0) = w; } }
    }
};
struct EpiMoe2 {
    static constexpr int PERM = 2;
    KP k; int l; const LAS int* tflat; const LAS float* tgate;
    __device__ __forceinline__ void operator()(const f32x4 (&acc)[2][2][4][2], const Unit& u, int wr, int wc, int fr, int fq) const {
        const KP kk = fresh(k); unsigned char* Y = as_global(kk->ws) + OFF_Y;
        const int c0 = u.pn * 256 + wc * 64 + 16 * fq; const float* bb = as_global(kk->in[I_BD]) + (size_t)(l * NE + u.e) * D;
        f32x4 bv[2][2];
#pragma unroll
        for (int bj = 0; bj < 2; ++bj)
#pragma unroll
            for (int n = 0; n < 2; ++n) bv[bj][n] = *(const f32x4*)(bb + c0 + 8 * bj + 4 * n);
#pragma unroll
        for (int ai = 0; ai < 2; ++ai)
#pragma unroll
            for (int m = 0; m < 4; ++m) { const int r = ai * 128 + wr * 64 + m * 16 + fr;
                if (r < u.nvalid) { const int flat = tflat[u.ui * 256 + r]; const float gt = tgate[u.ui * 256 + r] * Y8_SCALE; const float dq = 1.f / (W8_SCALE * H8_SCALE);
                    const f32x4 v00 = (acc[ai][0][m][0] * dq + bv[0][0]) * gt, v01 = (acc[ai][0][m][1] * dq + bv[0][1]) * gt, v10 = (acc[ai][1][m][0] * dq + bv[1][0]) * gt, v11 = (acc[ai][1][m][1] * dq + bv[1][1]) * gt;
                    u32x4 w; w.x = pk4_fp8_sat(v00.x, v00.y, v00.z, v00.w); w.y = pk4_fp8_sat(v01.x, v01.y, v01.z, v01.w); w.z = pk4_fp8_sat(v10.x, v10.y, v10.z, v10.w); w.w = pk4_fp8_sat(v11.x, v11.y, v11.z, v11.w);
                    *(u32x4*)(Y + (size_t)flat * D + c0) = w; } }
    }
};

template <bool FP8> __device__ __forceinline__ f32x4 mma_one(const bf16x8& b0, const bf16x8& b1, const bf16x8& a0, const bf16x8& a1, const f32x4& c, int kk) {
    if constexpr (FP8) { const i32x4 bl = __builtin_bit_cast(i32x4, b0), bh = __builtin_bit_cast(i32x4, b1), al = __builtin_bit_cast(i32x4, a0), ah = __builtin_bit_cast(i32x4, a1);
        const i32x8 bv = __builtin_shufflevector(bl, bh, 0, 1, 2, 3, 4, 5, 6, 7), av = __builtin_shufflevector(al, ah, 0, 1, 2, 3, 4, 5, 6, 7);
        return __builtin_amdgcn_mfma_scale_f32_16x16x128_f8f6f4(bv, av, c, 0, 0, 0, 0, 0, 0); }
    else return __builtin_amdgcn_mfma_f32_16x16x32_bf16(kk ? b1 : b0, kk ? a1 : a0, c, 0, 0, 0);
}
template <class Epi, class Sched, bool FP8 = false>
__device__ __forceinline__ void gemm_phase(LAS unsigned char* lds, KP k, size_t a_off, const Sched& S, const Epi& E, int wv) {
    const char* Abase = (const char*)(as_global(fresh(k)->ws) + a_off);
    const int tid = opaque_tid(wv), wid = __builtin_amdgcn_readfirstlane(tid >> 6), lane = tid & 63, wr = wid >> 2, wc = wid & 3, fr = lane & 15, fq = lane >> 4;
    constexpr int ROWB = Sched::ROWB, nt = ROWB / 128, KOFF = 1024;
    static_assert(FP8 == (ROWB == 1024), "operand row pitch");
    int sR[2], sC[2]; unsigned voffB[2];
#pragma unroll
    for (int i = 0; i < 2; ++i) { stage_rc(tid * 16 + i * 8192, sR[i], sC[i]); const int Rb = Epi::PERM == 1 ? ((sR[i] & ~31) + perm32(sR[i] & 31)) : Epi::PERM == 2 ? 64 * (sR[i] >> 5) + 16 * ((sR[i] & 15) >> 2) + 4 * ((sR[i] >> 4) & 1) + (sR[i] & 3) : sR[i]; voffB[i] = (unsigned)(Rb * ROWB + sC[i] * 2); }
    constexpr size_t kstep = 128, hstep = (size_t)(Epi::PERM == 2 ? 8 : HALF) * ROWB;
    const unsigned ldsw = (unsigned)wid * 1024u;
    const int fcol = fq * 8;
    const int aoff = lds_byte(wr * 64 + fr, fcol), boff = lds_byte(wc * 32 + fr, fcol);
#define PG8_SA(b, h) (((b) * 2 + (h)) * HTB)
#define PG8_SB(b, h) ((4 + (b) * 2 + (h)) * HTB)
#define PG8_STAGE(bufoff, gbase, voff) do { _Pragma("unroll") for (int _i = 0; _i < 2; ++_i) \
        __builtin_amdgcn_global_load_lds((const unsigned*)((const char*)(gbase) + (voff)[_i]), (LAS unsigned*)(lds + (bufoff) + ldsw + _i * 8192), 16, 0, 0); } while (0)
#define PG8_LDA(dst, b, h) do { _Pragma("unroll") for (int m = 0; m < 4; ++m) _Pragma("unroll") for (int k = 0; k < 2; ++k) dst[m][k] = *(const LAS bf16x8*)(lds + PG8_SA(b, h) + aoff + m * 2048 + k * KOFF); } while (0)
#define PG8_LDB(dst, b, h) do { _Pragma("unroll") for (int n = 0; n < 2; ++n) _Pragma("unroll") for (int k = 0; k < 2; ++k) dst[n][k] = *(const LAS bf16x8*)(lds + PG8_SB(b, h) + boff + n * 2048 + k * KOFF); } while (0)
#define PG8_MMA(ai, bj, At, Bt) do { __builtin_amdgcn_s_setprio(1); _Pragma("unroll") for (int m = 0; m < 4; ++m) _Pragma("unroll") for (int n = 0; n < 2; ++n) _Pragma("unroll") for (int k = 0; k < (FP8 ? 1 : 2); ++k) \
        acc[ai][bj][m][n] = mma_one<FP8>(Bt[n][0], Bt[n][1], At[m][0], At[m][1], acc[ai][bj][m][n], k); __builtin_amdgcn_s_setprio(0); } while (0)
#define PG8_WAIT_V(n) asm volatile("s_waitcnt vmcnt(" #n ")" ::: "memory")
#define PG8_WAIT_L(n) asm volatile("s_waitcnt lgkmcnt(" #n ")" ::: "memory")
#define PG8_BAR __builtin_amdgcn_s_barrier()
#define PG8_SCHED __builtin_amdgcn_sched_barrier(0)
    Unit cur, nxt; int ui = 0;
    if (!S.next(0, cur)) return;
    f32x4 acc[2][2][4][2];
#pragma unroll
    for (int a = 0; a < 2; ++a)
#pragma unroll
        for (int b = 0; b < 2; ++b)
#pragma unroll
            for (int m = 0; m < 4; ++m)
#pragma unroll
                for (int n = 0; n < 2; ++n) acc[a][b][m][n] = (f32x4){0.f, 0.f, 0.f, 0.f};
    bf16x8 At[4][2], B0[2][2], B1[2][2];
    unsigned voffA[2][2];
#pragma unroll
    for (int h = 0; h < 2; ++h)
#pragma unroll
        for (int i = 0; i < 2; ++i) voffA[h][i] = S.aoff(cur, 0, h * 128 + sR[i], sC[i]);
    const char* cB = cur.B;
#define PG8_KT(j, rot) ((size_t)(((j) + (rot)) & (nt - 1)) * kstep)
    int crot = cur.rot;
    { const size_t k0 = PG8_KT(0, crot), k1 = PG8_KT(1, crot);
    PG8_STAGE(PG8_SB(0, 0), cB + k0, voffB); PG8_STAGE(PG8_SB(0, 1), cB + hstep + k0, voffB); PG8_STAGE(PG8_SA(0, 0), Abase + k0, voffA[0]); PG8_STAGE(PG8_SA(0, 1), Abase + k0, voffA[1]);
    if (wr == 1) PG8_BAR;
    PG8_WAIT_V(2); PG8_BAR;
    PG8_STAGE(PG8_SB(1, 0), cB + k1, voffB); PG8_STAGE(PG8_SA(1, 0), Abase + k1, voffA[0]); PG8_STAGE(PG8_SB(1, 1), cB + hstep + k1, voffB); }
    PG8_WAIT_V(6); PG8_BAR;
    for (;;) {
        const bool has_next = S.next(ui + 1, nxt);
        const char* nB = has_next ? nxt.B : cB; const int nrot = has_next ? nxt.rot : 0;
        for (int t = 0; t < nt; t += 2) {
            const bool last = (t == nt - 2);
            const size_t o1 = PG8_KT(t + 1, crot), o2 = last ? PG8_KT(0, nrot) : PG8_KT(t + 2, crot), o3 = last ? PG8_KT(1, nrot) : PG8_KT(t + 3, crot);
            const char* a1 = Abase + o1;
            const char* a2 = Abase + o2; const char* b2 = (last ? nB : cB) + o2;
            const char* a3 = Abase + o3; const char* b3 = (last ? nB : cB) + o3;
            PG8_LDB(B0, 0, 0); PG8_LDB(B1, 0, 1); PG8_SCHED; PG8_LDA(At, 0, 0); PG8_STAGE(PG8_SA(1, 1), a1, voffA[1]);
            if (last && has_next) {
#pragma unroll
                for (int h = 0; h < 2; ++h)
#pragma unroll
                    for (int i = 0; i < 2; ++i) voffA[h][i] = S.aoff(nxt, ui + 1, h * 128 + sR[i], sC[i]);
            }
            PG8_WAIT_V(8); PG8_WAIT_L(0); PG8_BAR; PG8_MMA(0, 0, At, B0); PG8_MMA(0, 1, At, B1); PG8_BAR; PG8_SCHED;
            PG8_LDA(At, 0, 1); PG8_STAGE(PG8_SB(0, 0), b2, voffB); PG8_STAGE(PG8_SB(0, 1), b2 + hstep, voffB); PG8_STAGE(PG8_SA(0, 0), a2, voffA[0]);
            PG8_WAIT_V(8); PG8_WAIT_L(0); PG8_BAR; PG8_MMA(1, 0, At, B0); PG8_MMA(1, 1, At, B1); PG8_BAR; PG8_SCHED;
            PG8_LDB(B0, 1, 0); PG8_LDB(B1, 1, 1); PG8_SCHED; PG8_LDA(At, 1, 0); PG8_STAGE(PG8_SA(0, 1), a2, voffA[1]);
            PG8_WAIT_V(8); PG8_WAIT_L(0); PG8_BAR; PG8_MMA(0, 0, At, B0); PG8_MMA(0, 1, At, B1); PG8_BAR; PG8_SCHED;
            PG8_LDA(At, 1, 1); PG8_STAGE(PG8_SB(1, 0), b3, voffB); PG8_STAGE(PG8_SB(1, 1), b3 + hstep, voffB); PG8_STAGE(PG8_SA(1, 0), a3, voffA[0]);
            PG8_WAIT_V(8); PG8_WAIT_L(0); PG8_BAR; PG8_MMA(1, 0, At, B0); PG8_MMA(1, 1, At, B1); PG8_BAR; PG8_SCHED;
        }
        if (wr == 0) PG8_BAR;
        E(acc, cur, wr, wc, fr, fq);
        if (!has_next) break;
#pragma unroll
        for (int a = 0; a < 2; ++a)
#pragma unroll
            for (int b = 0; b < 2; ++b)
#pragma unroll
                for (int m = 0; m < 4; ++m)
#pragma unroll
                    for (int n = 0; n < 2; ++n) acc[a][b][m][n] = (f32x4){0.f, 0.f, 0.f, 0.f};
        cur = nxt; cB = nB; crot = nrot; ++ui;
        if (wr == 1) PG8_BAR;
    }
    PG8_WAIT_V(0);
    PG8_BAR;
#undef PG8_KT
#undef PG8_SA
#undef PG8_SB
#undef PG8_STAGE
#undef PG8_LDA
#undef PG8_LDB
#undef PG8_MMA
#undef PG8_WAIT_V
#undef PG8_WAIT_L
#undef PG8_BAR
#undef PG8_SCHED
}
}

typedef float f32x16 __attribute__((ext_vector_type(16)));
__device__ __forceinline__ void s5_lam(const Cx& p, int jd, int g, int pp, float& lbr, float& lbi, float& qr, float& qi) {
    const f32x4 t = *(const f32x4*)(as_global(p.k->ws) + OFF_S5T + (size_t)((jd * 64 + g) * 64 + pp) * 16); lbr = t.x; lbi = t.y; qr = t.z; qi = t.w;
}
__device__ __forceinline__ int s5_tbi(int d, int B, int st) { return (d * 136 + B) * 64 + (st ^ ((B & 15) << 2)); }
__device__ __forceinline__ int s5_row(int b, int B, int t) { return B < 8 ? b * NCTX + 32 * B + t : RCTX + b * SEQ + 32 * (B - 8) + t; }
__device__ __forceinline__ void ph_s5(const Cx& p, int l, LAS unsigned char* lds) {
    const int tid = opaque_tid(p.wv), lane = tid & 63, wave = p.wv, n = lane & 31, h = lane >> 5, j = l / 3; const bool last = (l == DEPTH - 1);
    const bf16_t* HN = (const bf16_t*)(as_global(p.k->ws) + OFF_HN); bf16_t* A2 = (bf16_t*)(as_global(p.k->ws) + OFF_A2);
    LAS unsigned* Tb = (LAS unsigned*)lds;
    for (int wg = blockIdx.x; wg < NBATCH * 64; wg += gridDim.x) {
        const int tid = opaque_tid(p.wv), lane = tid & 63, n = lane & 31, h = lane >> 5;
        const int b = wg >> 6, g = wg & 63;
        const bf16_t* HNs = HN + (size_t)(b * 64 + g) * (NCTX + SEQ) * 16;
        float lbr[2], lbi[2];
#pragma unroll
        for (int d = 0; d < 2; ++d) { const int jd = j * 2 + d; float qr, qi; s5_lam(p, jd, g, lane, lbr[d], lbi[d], qr, qi); }
        WG_SYNC();
        {
            LAS unsigned char* Ub = lds + 69632;
            const int d = wave >> 2, mt = wave & 3;
            const unsigned char* WTg = as_global(p.k->ws) + OFF_WT + (size_t)((j * 64 + g) * 2 + d) * 131072;
            bf16x8 wf[32];
#pragma unroll
            for (int s = 0; s < 32; ++s) wf[s] = *(const bf16x8*)(WTg + ((mt * 32 + s) * 64 + lane) * 16);
            u32x4 uv[4];
#pragma unroll
            for (int q = 0; q < 4; ++q) { const int pc = tid + NTHR * q; uv[q] = *(const u32x4*)(HNs + (size_t)(pc >> 1) * 16 + 8 * (pc & 1)); }
#pragma unroll 1
            for (int nt = 0; nt < 5; ++nt) {
                WG_SYNC();
#pragma unroll
                for (int q = 0; q < 4; ++q) { const int pc = tid + NTHR * q, tk = pc >> 1, hf = pc & 1, nn = tk >> 5, s = tk & 31;
                    *(LAS u32x4*)(Ub + s * 1024 + ((nn ^ s) & 31) * 32 + hf * 16) = uv[q]; }
                WG_SYNC();
                if (nt < 4) {
#pragma unroll
                    for (int q = 0; q < 4; ++q) { const int pc = tid + NTHR * q, tok = 1024 * (nt + 1) + (pc >> 1);
                        uv[q] = (u32x4){0u, 0u, 0u, 0u}; if (tok < NCTX + SEQ) uv[q] = *(const u32x4*)(HNs + (size_t)tok * 16 + 8 * (pc & 1)); } }
                f32x16 e0, e1;
#pragma unroll
                for (int q = 0; q < 16; ++q) { e0[q] = 0.f; e1[q] = 0.f; }
#pragma unroll
                for (int s = 0; s < 32; s += 2) {
                    e0 = __builtin_amdgcn_mfma_f32_32x32x16_bf16(wf[s], *(const LAS bf16x8*)(Ub + s * 1024 + ((n ^ s) & 31) * 32 + h * 16), e0, 0, 0, 0);
                    e1 = __builtin_amdgcn_mfma_f32_32x32x16_bf16(wf[s + 1], *(const LAS bf16x8*)(Ub + (s + 1) * 1024 + ((n ^ (s + 1)) & 31) * 32 + h * 16), e1, 0, 0, 0); }
                const int B = 32 * nt + n;
                if (B < 136) {
#pragma unroll
                    for (int q = 0; q < 4; ++q) { u32x2 o; o.x = pk2(e0[4 * q] + e1[4 * q], e0[4 * q + 1] + e1[4 * q + 1]); o.y = pk2(e0[4 * q + 2] + e1[4 * q + 2], e0[4 * q + 3] + e1[4 * q + 3]);
                        *(LAS u32x2*)(Tb + (d * 136 + B) * 64 + 16 * mt + 4 * q + 2 * h) = o; } }
            }
        }
        WG_SYNC();
        {
            const int tid = opaque_tid(p.wv), lane = tid & 63, n = lane & 31, h = lane >> 5;
            LAS unsigned char* Ub = lds + 69632;
            LAS unsigned char* KTl = lds + 102400;
            { const unsigned char* KTg = as_global(p.k->ws) + OFF_KT + (size_t)(j * 64 + g) * 33792;
              for (int pc = tid; pc < 2112; pc += NTHR) *(LAS u32x4*)(KTl + pc * 16) = *(const u32x4*)(KTg + pc * 16); }
            const unsigned char* GTg = as_global(p.k->ws) + OFF_GT + (size_t)(j * 64 + g) * 262144;
            const int m0 = wave, m1 = 15 - wave, toff = n >> 4, hh = n & 15;
            bf16x8 gf[2][2][8];
#pragma unroll
            for (int d = 0; d < 2; ++d)
#pragma unroll
                for (int mi = 0; mi < 2; ++mi)
#pragma unroll
                    for (int ks = 0; ks < 8; ++ks) gf[d][mi][ks] = *(const bf16x8*)(GTg + d * 131072 + (((mi ? m1 : m0) * 8 + ks) * 64 + lane) * 16);
            const float* dd = as_global(p.k->in[I_S5D]) + j * D + 16 * g; const f32x4 dv0 = *(const f32x4*)(dd + 4 * h), dv1 = *(const f32x4*)(dd + 8 + 4 * h);
            const int offF = ((toff + 1) * 16 + hh) * 32 + h * 16, offR = ((34 - toff) * 16 + hh) * 32 + h * 16;
            unsigned char* A2b = (unsigned char*)A2;
            u32x4 uv[4];
#pragma unroll
            for (int q = 0; q < 4; ++q) { const int pc = tid + NTHR * q; uv[q] = *(const u32x4*)(HNs + (size_t)(pc >> 1) * 16 + 8 * (pc & 1)); }
        if (wave < 2) { const int d = wave; float ar = lbr[d], ai = lbi[d];
#pragma unroll
            for (int q = 0; q < 5; ++q) { const float t2 = ar * ar - ai * ai; ai = 2.f * ar * ai; ar = t2; }
            float hr = 0.f, hi = 0.f;
            for (int i = 0; i < 136; ++i) { const int B = d == 0 ? i : (i < 8 ? 7 - i : 143 - i);
                LAS unsigned* slot = Tb + (d * 136 + B) * 64 + lane; const unsigned e = *slot; *slot = pk2(hr, hi);
                const float er = __uint_as_float(e << 16), ei = __uint_as_float(e & 0xffff0000u);
                const float nr = ar * hr - ai * hi + er, ni = ar * hi + ai * hr + ei; hr = nr; hi = ni; }
        }
        WG_SYNC();
            for (int idx = tid; idx < 272 * 16; idx += NTHR) { const int row = idx >> 4, c = idx & 15, x = (row >= 136 ? row - 136 : row) & 15, c2 = c ^ x;
                if (c < c2) { LAS u32x4* pa = (LAS u32x4*)(Tb + row * 64 + c * 4); LAS u32x4* pb = (LAS u32x4*)(Tb + row * 64 + c2 * 4); const u32x4 va = *pa, vb = *pb; *pa = vb; *pb = va; } }
#pragma unroll 1
            for (int nt = 0; nt < 5; ++nt) {
                WG_SYNC();
#pragma unroll
                for (int q = 0; q < 4; ++q) { const int pc = tid + NTHR * q, tk = pc >> 1, hf = pc & 1, nn = tk >> 5, s = tk & 31;
                    *(LAS u32x4*)(Ub + s * 1024 + ((nn ^ s) & 31) * 32 + hf * 16) = uv[q]; }
                WG_SYNC();
                f32x16 aF0, aF1;
#pragma unroll
                for (int q = 0; q < 16; ++q) { aF0[q] = 0.f; aF1[q] = 0.f; }
#pragma unroll 4
                for (int s = 0; s < 32; ++s) {
                    const bf16x8 bu = *(const LAS bf16x8*)(Ub + s * 1024 + ((n ^ s) & 31) * 32 + h * 16);
                    const int o0 = s <= 2 * m0 + 1 ? offF + (2 * m0 - s) * 512 : offR + (s - 2 * m0) * 512, o1 = s <= 2 * m1 + 1 ? offF + (2 * m1 - s) * 512 : offR + (s - 2 * m1) * 512;
                    aF0 = __builtin_amdgcn_mfma_f32_32x32x16_bf16(*(const LAS bf16x8*)(KTl + o0), bu, aF0, 0, 0, 0); aF1 = __builtin_amdgcn_mfma_f32_32x32x16_bf16(*(const LAS bf16x8*)(KTl + o1), bu, aF1, 0, 0, 0);
                }
#pragma unroll
                for (int e = 0; e < 2; ++e) { const int s0 = 2 * m0 + e, s1 = 2 * m1 + e;
                    const bf16x8 b0 = *(const LAS bf16x8*)(Ub + s0 * 1024 + ((n ^ s0) & 31) * 32 + h * 16), b1 = *(const LAS bf16x8*)(Ub + s1 * 1024 + ((n ^ s1) & 31) * 32 + h * 16);
                    const bf16x8 ar = *(const LAS bf16x8*)(KTl + offR + e * 512);
                    aF0 = __builtin_amdgcn_mfma_f32_32x32x16_bf16(ar, b0, aF0, 0, 0, 0); aF1 = __builtin_amdgcn_mfma_f32_32x32x16_bf16(ar, b1, aF1, 0, 0, 0); }
                const int Bc = min(32 * nt + n, 135);
#pragma unroll
                for (int ks = 0; ks < 8; ++ks) {
                    const bf16x8 h0 = *(const LAS bf16x8*)(Tb + s5_tbi(0, Bc, 8 * ks + 4 * h)), h1 = *(const LAS bf16x8*)(Tb + s5_tbi(1, Bc, 8 * ks + 4 * h));
                    aF0 = __builtin_amdgcn_mfma_f32_32x32x16_bf16(gf[0][0][ks], h0, aF0, 0, 0, 0); aF1 = __builtin_amdgcn_mfma_f32_32x32x16_bf16(gf[0][1][ks], h0, aF1, 0, 0, 0);
                    aF0 = __builtin_amdgcn_mfma_f32_32x32x16_bf16(gf[1][0][ks], h1, aF0, 0, 0, 0); aF1 = __builtin_amdgcn_mfma_f32_32x32x16_bf16(gf[1][1][ks], h1, aF1, 0, 0, 0);
                    if (ks & 1) __builtin_amdgcn_sched_barrier(0);
                }
                if (nt < 4) {
#pragma unroll
                    for (int q = 0; q < 4; ++q) { const int pc = tid + NTHR * q, tok = 1024 * (nt + 1) + (pc >> 1);
                        uv[q] = (u32x4){0u, 0u, 0u, 0u}; if (tok < NCTX + SEQ) uv[q] = *(const u32x4*)(HNs + (size_t)tok * 16 + 8 * (pc & 1)); } }
                {   LAS unsigned char* scr = lds + 140288 + wave * 2048;
#pragma unroll
                    for (int mi = 0; mi < 2; ++mi) { const int m = mi ? m1 : m0; const f32x16 y = mi ? aF1 : aF0;
#pragma unroll
                        for (int q4 = 0; q4 < 4; ++q4) { const int t = 2 * m + (q4 >> 1), c0 = 8 * (q4 & 1) + 4 * h;
                            const u32x2 uw = *(const LAS u32x2*)(Ub + t * 1024 + ((n ^ t) & 31) * 32 + c0 * 2); const f32x4 d4 = (q4 & 1) ? dv1 : dv0;
                            *(LAS unsigned*)(scr + ((mi * 2 + (q4 >> 1)) * 32 + n) * 16 + c0) = pk4_fp8_sat(gelu_tanh(y[4 * q4] + d4.x * bf2f(uw.x & 0xffffu)), gelu_tanh(y[4 * q4 + 1] + d4.y * bf2f(uw.x >> 16)),
                                                                                                              gelu_tanh(y[4 * q4 + 2] + d4.z * bf2f(uw.y & 0xffffu)), gelu_tanh(y[4 * q4 + 3] + d4.w * bf2f(uw.y >> 16))); } }
                    asm volatile("s_waitcnt lgkmcnt(0)" ::: "memory");
#pragma unroll
                    for (int k2 = 0; k2 < 2; ++k2) { const int sl = lane + 64 * k2, ti = sl >> 5, B = 32 * nt + (sl & 31), t = 2 * ((ti >> 1) ? m1 : m0) + (ti & 1);
                        const u32x4 o = *(const LAS u32x4*)(scr + sl * 16);
                        if (B < 136 && !(last && B < 8)) *(u32x4*)(A2b + (size_t)s5_row(b, B, t) * D + 16 * g) = o; }
                    asm volatile("s_waitcnt lgkmcnt(0)" ::: "memory");
                }
            }
        }
    }
}
__device__ __forceinline__ void ph_conv3(const Cx& p) {
    const bf16_t* Z = (const bf16_t*)(as_global(p.k->ws) + OFF_Z); bf16_t* A2 = (bf16_t*)(as_global(p.k->ws) + OFF_A2); const float* cw = as_global(p.k->in[I_SCCW]);
    const int tid = opaque_tid(p.wv);
    for (size_t i = (size_t)blockIdx.x * NTHR + tid; i < (size_t)RTOT * D / 4; i += (size_t)gridDim.x * NTHR) {
        const int row = (int)(i >> 8), col = (int)(i & 255) * 4;
        int pos, len; if (row < RCTX) { pos = row & 255; len = 256; } else { pos = (row - RCTX) & 63; len = 64; }
        f32x4 acc = (f32x4){0.f, 0.f, 0.f, 0.f};
#pragma unroll
        for (int d = 0; d < 3; ++d) { const int q = pos + d - 1; const bool ok = (q >= 0 && q < len);
            const bf16_t* zr = Z + (size_t)(ok ? row + d - 1 : row) * 2048; const f32x4 uu = ld_bf16x4(zr + col); f32x4 w = *(const f32x4*)(cw + d * D + col);
            if (!ok) w = (f32x4){0.f, 0.f, 0.f, 0.f};
            acc += w * uu; }
        const u32x2 gw = __builtin_nontemporal_load((const u32x2*)(Z + (size_t)row * 2048 + 1024 + col)); const f32x4 gb = (f32x4){bf2f(gw.x & 0xffffu), bf2f(gw.x >> 16), bf2f(gw.y & 0xffffu), bf2f(gw.y >> 16)}, o = gb * acc;
        *(unsigned*)((unsigned char*)A2 + (size_t)row * D + col) = pk4_fp8_sat(o.x, o.y, o.z, o.w);
    }
}
__device__ __forceinline__ void cf_ln_silu_store(const Cx& p, f32x4 (&a)[4], unsigned char* dst, int lane) {
    float s = 0.f;
#pragma unroll
    for (int j = 0; j < 4; ++j) s += (a[j].x + a[j].y) + (a[j].z + a[j].w);
    const float mu = wave_sum(s) * (1.f / D); float q2 = 0.f;
#pragma unroll
    for (int j = 0; j < 4; ++j) { a[j] = a[j] - mu; q2 += (a[j].x * a[j].x + a[j].y * a[j].y) + (a[j].z * a[j].z + a[j].w * a[j].w); }
    const float rstd = rsqrtf(wave_sum(q2) * (1.f / D) + 1e-5f);
    f32x4 o[4];
#pragma unroll
    for (int j = 0; j < 4; ++j) { const int col = 256 * j + 4 * lane; const f32x4 y = a[j] * rstd * *(const f32x4*)(as_global(p.k->in[I_LNG]) + col) + *(const f32x4*)(as_global(p.k->in[I_LNB]) + col);
        o[j] = (f32x4){silu(y.x), silu(y.y), silu(y.z), silu(y.w)}; }
    store_row_fp8(dst, lane, o);
}
__device__ __forceinline__ void ph_conv31(const Cx& p, LAS unsigned char* lds) {
    const int tid = opaque_tid(p.wv), lane = tid & 63, wave = p.wv;
    const bf16_t* U = (const bf16_t*)(as_global(p.k->ws) + OFF_Z); unsigned char* A2 = as_global(p.k->ws) + OFF_A2; bf16_t* T2 = (bf16_t*)(as_global(p.k->ws) + OFF_HN);
    const float* dw = as_global(p.k->in[I_DWW]);
    for (int item = blockIdx.x; item < NBATCH * 64; item += gridDim.x) {
        const int base = RCTX + (item >> 6) * SEQ + (item & 63);
        WG_SYNC();
#pragma unroll 4
        for (int q = 0; q < 16; ++q) { const int ch = tid + NTHR * q, r = ch >> 7, o16 = ch & 127;
            *(LAS u32x4*)(lds + r * 2048 + o16 * 16) = __builtin_nontemporal_load((const u32x4*)(U + (size_t)(base + 64 * r) * D + o16 * 8)); }
        WG_SYNC();
#pragma unroll 1
        for (int pass = 0; pass < 2; ++pass) {
            const int c0 = 128 * wave + 64 * pass + lane; const LAS unsigned char* col = lds + c0 * 2;
            float w0[31];
#pragma unroll
            for (int d = 0; d < 31; ++d) w0[d] = dw[d * D + c0];
            const float bb = as_global(p.k->in[I_DWB])[c0];
#pragma unroll 1
            for (int blk = 0; blk < 8; ++blk) {
                float in[38];
#pragma unroll
                for (int j = 0; j < 38; ++j) { const int rr = 8 * blk - 15 + j; const int rc = rr < 0 ? 0 : (rr > 63 ? 63 : rr);
                    const float v = __uint_as_float((unsigned)*(const LAS unsigned short*)(col + rc * 2048) << 16); in[j] = (rr >= 0 && rr < 64) ? v : 0.f; }
#pragma unroll
                for (int q = 0; q < 8; ++q) { float a0 = bb;
#pragma unroll
                    for (int d = 0; d < 31; ++d) a0 = fmaf(w0[d], in[q + d], a0);
                    *(unsigned short*)(T2 + (size_t)(base + 64 * (8 * blk + q)) * D + c0) = (unsigned short)(pk2(a0, 0.f) & 0xffffu); }
            }
        }
        asm volatile("s_waitcnt vmcnt(0)" ::: "memory");
        WG_SYNC();
        for (int r = wave; r < 64; r += NWV) { f32x4 a[4]; const bf16_t* pr = T2 + (size_t)(base + 64 * r) * D;
#pragma unroll
            for (int j = 0; j < 4; ++j) a[j] = ld_bf16x4(pr + 256 * j + 4 * lane);
            cf_ln_silu_store(p, a, A2 + (size_t)(base + 64 * r) * D, lane); }
    }
    for (int row = blockIdx.x * NWV + wave; row < RCTX; row += gridDim.x * NWV) {
        const int pos = row & 255, base = row - pos;
        f32x4 a[4];
#pragma unroll
        for (int j = 0; j < 4; ++j) a[j] = *(const f32x4*)(as_global(p.k->in[I_DWB]) + 256 * j + 4 * lane);
        for (int d = 0; d < 31; ++d) { const int q = pos + d - 15;
            if (q >= 0 && q < 256) { const bf16_t* ur = U + (size_t)(base + q) * D;
#pragma unroll
                for (int j = 0; j < 4; ++j) { const int col = 256 * j + 4 * lane; a[j] += *(const f32x4*)(dw + d * D + col) * ld_bf16x4(ur + col); } } }
        cf_ln_silu_store(p, a, A2 + (size_t)row * D, lane);
    }
}
__device__ __forceinline__ void ph_route(const Cx& p, int l, LAS unsigned char* lds) {
    const int tid = opaque_tid(p.wv), lane = tid & 63, wave = p.wv, n = lane & 31, h = lane >> 5;
    const bf16_t* X = (const bf16_t*)(as_global(p.k->ws) + OFF_X); bf16_t* F = (bf16_t*)(as_global(p.k->ws) + OFF_F); const float* mod = (const float*)(as_global(p.k->ws) + OFF_MOD);
    float* gate = (float*)(as_global(p.k->ws) + OFF_GATE); int* elist = (int*)(as_global(p.k->ws) + OFF_ELIST); unsigned* cnt = (unsigned*)(as_global(p.k->ws) + OFF_CTL) + CW_CNT + l * 32;
    const float* rb = as_global(p.k->in[I_RB]) + l * NE;
    constexpr int TS = 2064;
    LAS unsigned char* tile = lds;
    LAS float* part = (LAS float*)(lds + 32 * TS);
    LAS int* lcnt = (LAS int*)(lds + 32 * TS + 32768);
    LAS int* choice = lcnt + 64;
    const int row_lo = (l == DEPTH - 1) ? RCTX : 0, nrows = RTOT - row_lo, G = gridDim.x;
    const int per = (nrows + G - 1) / G, r0 = row_lo + blockIdx.x * per, r1 = min(r0 + per, RTOT);
    bf16x8 Bw[8];
    { const bf16_t* rt = (const bf16_t*)(as_global(p.k->ws) + OFF_RWT) + ((size_t)l * NE + n) * D + 128 * wave + 8 * h;
#pragma unroll
      for (int s = 0; s < 8; ++s) Bw[s] = *(const bf16x8*)(rt + 16 * s); }
    if (tid < 32) lcnt[tid] = 0;
    WG_SYNC();
    for (int rb0 = r0; rb0 < r1; rb0 += 32) {
        const int nb = min(32, r1 - rb0);
        for (int q = wave; q < 32; q += NWV) {
            if (q < nb) { const int row = rb0 + q; f32x4 v[4], f[4]; load_row_bf16(X + (size_t)row * D, lane, v);
                const float rs = rsqrtf(row_sumsq(v) * (1.f / D) + 1e-6f);
                const float* m = mod + (size_t)(l * 5 + row_bi(row)) * 6144;
                norm_mod(v, rs, as_global(p.k->in[I_N2G]) + l * D, m + 4096, m + 3072, lane, f);
#pragma unroll
                for (int j = 0; j < 4; ++j) { u32x2 w; w.x = pk2(f[j].x, f[j].y); w.y = pk2(f[j].z, f[j].w);
                    *(unsigned*)((unsigned char*)F + (size_t)row * D + 256 * j + 4 * lane) = pk4_fp8_sat(f[j].x, f[j].y, f[j].z, f[j].w); *(LAS u32x2*)(tile + q * TS + (256 * j + 4 * lane) * 2) = w; }
            } else {
#pragma unroll
                for (int j = 0; j < 4; ++j) *(LAS u32x2*)(tile + q * TS + (256 * j + 4 * lane) * 2) = (u32x2){0u, 0u};
            }
        }
        WG_SYNC();
        { f32x16 acc;
#pragma unroll
          for (int i = 0; i < 16; ++i) acc[i] = 0.f;
#pragma unroll
          for (int s = 0; s < 8; ++s) { const bf16x8 af = *(const LAS bf16x8*)(tile + n * TS + (128 * wave + 16 * s + 8 * h) * 2); acc = __builtin_amdgcn_mfma_f32_32x32x16_bf16(af, Bw[s], acc, 0, 0, 0); }
#pragma unroll
          for (int r = 0; r < 16; ++r) { const int t = (r & 3) + 8 * (r >> 2) + 4 * h; part[(wave * 32 + t) * 32 + n] = acc[r]; } }
        WG_SYNC();
        if (tid < nb) { const int row = rb0 + tid;
            float lg[32];
#pragma unroll
            for (int e4 = 0; e4 < 8; ++e4) { f32x4 s = *(const f32x4*)(rb + 4 * e4);
#pragma unroll
                for (int w = 0; w < 8; ++w) s += *(const LAS f32x4*)(part + (w * 32 + tid) * 32 + 4 * e4);
                lg[4 * e4] = s.x; lg[4 * e4 + 1] = s.y; lg[4 * e4 + 2] = s.z; lg[4 * e4 + 3] = s.w; }
            float bv[4]; int bx[4]; unsigned taken = 0u;
#pragma unroll
            for (int k = 0; k < 4; ++k) { float best = -3.0e38f; int idx = 0;
#pragma unroll
                for (int e = 0; e < 32; ++e) { const bool c = !((taken >> e) & 1u) && lg[e] > best; best = c ? lg[e] : best; idx = c ? e : idx; }
                taken |= 1u << idx; bv[k] = best; bx[k] = idx; }
            const float e1 = __expf(bv[1] - bv[0]), e2 = __expf(bv[2] - bv[0]), e3 = __expf(bv[3] - bv[0]), inv = 1.f / (1.f + e1 + e2 + e3);
            *(f32x4*)(gate + (size_t)row * 4) = (f32x4){inv, e1 * inv, e2 * inv, e3 * inv};
#pragma unroll
            for (int k = 0; k < 4; ++k) { const int rank = __hip_atomic_fetch_add(lcnt + bx[k], 1, __ATOMIC_RELAXED, __HIP_MEMORY_SCOPE_WORKGROUP); choice[(row - r0) * 4 + k] = bx[k] | (rank << 8); }
        }
        WG_SYNC();
    }
    if (tid < 32) { const int c = lcnt[tid]; lcnt[32 + tid] = c ? (int)atomicAdd(&cnt[tid], (unsigned)c) : 0; }
    WG_SYNC();
    for (int i = tid; i < (r1 - r0) * 4; i += NTHR) { const int c = choice[i], e = c & 0xff, rank = c >> 8; elist[e * CAP + lcnt[32 + e] + rank] = (r0 + (i >> 2)) * 4 + (i & 3); }
}
__device__ __forceinline__ void ph_combine(const Cx& p, int l) {
    const int tid = opaque_tid(p.wv), lane = tid & 63, wave = tid >> 6; const bool last = (l == DEPTH - 1);
    bf16_t* X = (bf16_t*)(as_global(p.k->ws) + OFF_X); bf16_t* HN = (bf16_t*)(as_global(p.k->ws) + OFF_HN); const bf16_t* Y = (const bf16_t*)(as_global(p.k->ws) + OFF_Y); const float* mod = (const float*)(as_global(p.k->ws) + OFF_MOD);
    const int row_lo = last ? RCTX : 0;
    for (int row = row_lo + blockIdx.x * NWV + wave; row < RTOT; row += gridDim.x * NWV) {
        f32x4 v[4], o[4]; load_row_bf16(X + (size_t)row * D, lane, v);
        const float* m = mod + (size_t)(l * 5 + row_bi(row)) * 6144;
#pragma unroll
        for (int j = 0; j < 4; ++j) { const int col = 256 * j + 4 * lane; const unsigned char* y = (const unsigned char*)Y + (size_t)row * 4 * D + col;
            f32x4 s = (f32x4){0.f, 0.f, 0.f, 0.f};
#pragma unroll
            for (int q = 0; q < 4; ++q) { const int w = __builtin_nontemporal_load((const int*)(y + q * D)); const f32x2 lo = __builtin_amdgcn_cvt_pk_f32_fp8(w, false), hi = __builtin_amdgcn_cvt_pk_f32_fp8(w, true); s += (f32x4){lo.x, lo.y, hi.x, hi.y}; }
            v[j] += *(const f32x4*)(m + 5120 + col) * (s * (1.f / Y8_SCALE)); }
        const float rs = rsqrtf(row_sumsq(v) * (1.f / D) + 1e-6f);
        if (last) {
            float* op = as_global(p.k->out) + (size_t)(row - RCTX) * D;
#pragma unroll
            for (int j = 0; j < 4; ++j) { const int col = 256 * j + 4 * lane; *(f32x4*)(op + col) = v[j] * rs * *(const f32x4*)(as_global(p.k->in[I_FING]) + col); }
        } else {
            store_row_bf16(X + (size_t)row * D, lane, v);
            const float* m2 = mod + (size_t)((l + 1) * 5 + row_bi(row)) * 6144;
            norm_mod(v, rs, as_global(p.k->in[I_N1G]) + (l + 1) * D, m2 + 1024, m2, lane, o);
            if ((l + 1) % 3 == 0) store_row_s5(HN, row, lane, o); else if ((l + 1) % 3 == 2) store_row_fp8((unsigned char*)HN + (size_t)row * D, lane, o);
            else store_row_bf16(HN + (size_t)row * D, lane, o);
        }
    }
}

__device__ __forceinline__ int moe_setup(const Cx& p, int l, LAS unsigned char* lds, int NTl, bool gather) {
    LAS int* pt = (LAS int*)(lds + LDS_MISC); LAS int* desc = (LAS int*)(lds + LDS_MISC + 512); LAS int* tab = (LAS int*)(lds + LDS_MISC + 1024);
    const int tid = opaque_tid(p.wv), G = gridDim.x, c = blockIdx.x;
    const int* cnt = (const int*)(as_global(p.k->ws) + OFF_CTL) + CW_CNT + l * 32; const int* elist = (const int*)(as_global(p.k->ws) + OFF_ELIST);
    WG_SYNC();
    if (tid == 0) { int s = 0; for (int e = 0; e < 32; ++e) { pt[e] = s; s += (cnt[e] + 255) >> 8; } pt[32] = s; }
    WG_SYNC();
    const int TMt = pt[32], S8 = G >> 3, x8 = c & 7, s8 = c >> 3, lo8 = (x8 * TMt) >> 3, ux = ((((x8 + 1) * TMt) >> 3) - lo8) * NTl;
    int nu = ux > s8 ? (ux - s8 + S8 - 1) / S8 : 0; if (nu > g8::MOE_MAX_UNITS) nu = g8::MOE_MAX_UNITS;
    if (tid < nu) { const int q = tid * S8 + s8, al = q / NTl, mg = lo8 + al; int pn = q % NTl; pn |= ((NTl == 8 ? pn + 2 * al : 2 * pn + al) & 7) << 8; int e = 0;
        for (int q = 1; q < 32; ++q) if (pt[q] <= mg) e = q;
        const int mt = mg - pt[e]; const int nv = min(256, cnt[e] - mt * 256);
        desc[4 * tid] = e; desc[4 * tid + 1] = mg; desc[4 * tid + 2] = nv | (mt << 16); desc[4 * tid + 3] = pn; }
    WG_SYNC();
    if (gather) {
        const int nt_ = nu < g8::MOE_TAB_UNITS ? nu : g8::MOE_TAB_UNITS;
        for (int i = tid; i < nt_ * 256; i += NTHR) { const int ui = i >> 8, r = i & 255; const int e = desc[4 * ui], nvm = desc[4 * ui + 2], nv = nvm & 0xffff, mt = nvm >> 16;
            tab[i] = r < nv ? (elist[e * CAP + mt * 256 + r] >> 2) * 1024 : 0; }
        if (nu > g8::MOE_TAB_UNITS) nu = g8::MOE_TAB_UNITS;
        WG_SYNC();
    } else {
        if (nu > 6) nu = 6;
        const float* gate = (const float*)(as_global(p.k->ws) + OFF_GATE); LAS float* tg = (LAS float*)(tab + 2048);
        for (int i = tid; i < nu * 256; i += NTHR) { const int ui = i >> 8, r = i & 255; const int e = desc[4 * ui], nvm = desc[4 * ui + 2], nv = nvm & 0xffff, mt = nvm >> 16;
            const int flat = r < nv ? elist[e * CAP + mt * 256 + r] : 0; tab[i] = flat; tg[i] = r < nv ? gate[flat] : 0.f; }
        WG_SYNC();
    }
    return __builtin_amdgcn_readfirstlane(nu);
}
enum { PH_PREP = 0, PH_MOD, PH_NORM0, PH_S5, PH_S5POST, PH_GLU, PH_SCIN, PH_CONV3, PH_SCOUT, PH_PW1, PH_CONV31, PH_PW2, PH_ROUTE, PH_MOE1, PH_MOE2, PH_COMBINE };

template <int PH> __device__ __forceinline__ void run_phase(const Cx& p_in, int l, LAS unsigned char* lds) {
    Cx p = p_in; asm volatile("" : "+s"(p.k));
    const int G = gridDim.x, c = blockIdx.x;
    if constexpr (PH == PH_PREP) ph_prep(p, lds);
    if constexpr (PH == PH_MOD) ph_mod(p, lds);
    if constexpr (PH == PH_NORM0) ph_norm_first(p);
    if constexpr (PH == PH_S5) ph_s5(p, l, lds);
    if constexpr (PH == PH_CONV3) ph_conv3(p);
    if constexpr (PH == PH_CONV31) ph_conv31(p, lds);
    if constexpr (PH == PH_ROUTE) { if (l > 0) { const int pk = (l - 1) % 3; const int covered = pk == 0 ? tail_cap(68 * 8, G) : pk == 1 ? tail_cap(68 * 12, G) + tail_cap(68 * 4, G) : tail_cap(68 * 8, G) + tail_cap(68 * 4, G);
            conv_catchup(p, lds, l, covered); }
        ph_route(p, l, lds); }
    if constexpr (PH == PH_COMBINE) ph_combine(p, l);
    if constexpr (PH == PH_GLU) { const bool last = (l == DEPTH - 1);
        g8::SchedDense8 S{p.k, OFF_WGLU + (size_t)(l / 3) * 2 * MiB, last ? RCTX : 0, last ? 64 : 68, 8, G, c}; g8::EpiGluRes E{p.k, l};
        g8::gemm_phase<g8::EpiGluRes, g8::SchedDense8, true>(lds, p.k, OFF_A2, S, E, p.wv);
        if (!last) tail_convert(p, lds, l + 1, 0, 68 * 8); }
    if constexpr (PH == PH_SCIN) { g8::SchedDense S{p.k, OFF_WSCIN, 0, 68, 12, G, c}; g8::EpiScin E{p.k}; g8::gemm_phase(lds, p.k, OFF_HN, S, E, p.wv); tail_convert(p, lds, l + 1, 0, 68 * 12); }
    if constexpr (PH == PH_SCOUT) { g8::SchedDense8 S{p.k, OFF_WSCOUT, 0, 68, 4, G, c}; g8::EpiRes E{p.k, l, -1}; g8::gemm_phase<g8::EpiRes, g8::SchedDense8, true>(lds, p.k, OFF_A2, S, E, p.wv); tail_convert(p, lds, l + 1, tail_cap(68 * 12, G), 68 * 4); }
    if constexpr (PH == PH_PW1) { g8::SchedDense8 S{p.k, OFF_WPW1, 0, 68, 8, G, c}; g8::EpiPairBf16<0> E{p.k, l}; g8::gemm_phase<g8::EpiPairBf16<0>, g8::SchedDense8, true>(lds, p.k, OFF_HN, S, E, p.wv); tail_convert(p, lds, l + 1, 0, 68 * 8); }
    if constexpr (PH == PH_PW2) { g8::SchedDense8 S{p.k, OFF_WPW2, 0, 68, 4, G, c}; g8::EpiRes E{p.k, l, I_PW2B}; g8::gemm_phase<g8::EpiRes, g8::SchedDense8, true>(lds, p.k, OFF_A2, S, E, p.wv); tail_convert(p, lds, l + 1, tail_cap(68 * 8, G), 68 * 4); }
    if constexpr (PH == PH_MOE1) { const int nu = moe_setup(p, l, lds, 8, true);
        g8::SchedMoe S{p.k, OFF_WGU + (size_t)l * 64 * MiB, (size_t)2 * MiB, (const LAS int*)(lds + LDS_MISC + 512), (const LAS int*)(lds + LDS_MISC + 1024), nu, true};
        g8::EpiPairBf16<1> E{p.k, l}; g8::gemm_phase<g8::EpiPairBf16<1>, g8::SchedMoe, true>(lds, p.k, OFF_F, S, E, p.wv); }
    if constexpr (PH == PH_MOE2) { const int nu = moe_setup(p, l, lds, 4, false);
        g8::SchedMoe S{p.k, OFF_WD + (size_t)l * 32 * MiB, (size_t)1 * MiB, (const LAS int*)(lds + LDS_MISC + 512), (const LAS int*)(lds + LDS_MISC + 1024), nu, false};
        g8::EpiMoe2 E{p.k, l, (const LAS int*)(lds + LDS_MISC + 1024), (const LAS float*)(lds + LDS_MISC + 1024 + 8192)}; g8::gemm_phase<g8::EpiMoe2, g8::SchedMoe, true>(lds, p.k, OFF_HM, S, E, p.wv); }
}

#define NO_PK_F32 __attribute__((target("no-packed-fp32-ops")))
template <int PH> __global__ void NO_PK_F32 __launch_bounds__(NTHR, 2) k_ph(P p0, int l) {
    extern __shared__ __attribute__((aligned(16))) unsigned char shm[];
    Cx p; p.k = (KP)__builtin_amdgcn_kernarg_segment_ptr(); p.wv = __builtin_amdgcn_readfirstlane(threadIdx.x >> 6);
    run_phase<PH>(p, l, (LAS unsigned char*)shm);
}
#ifndef MK_MULTI
__global__ void NO_PK_F32 __launch_bounds__(NTHR, 2) fwd(P p0) {
    extern __shared__ __attribute__((aligned(16))) unsigned char shm[];
    LAS unsigned char* lds = (LAS unsigned char*)shm;
    Cx p; p.k = (KP)__builtin_amdgcn_kernarg_segment_ptr(); p.wv = __builtin_amdgcn_readfirstlane(threadIdx.x >> 6);
    volatile LAS unsigned* bst = (volatile LAS unsigned*)(lds + LDS_MISC + 256);
    if (threadIdx.x == 0) { bst[0] = 0u; bst[1] = 0u; bst[2] = 0u; bst[3] = 0u; }
    WG_SYNC();
    (void)xcd_barrier_post((unsigned*)(as_global(p.k->ws) + OFF_CTL) + CW_BAR, bst);
#define GRID_BAR() do { XcdBarrier b_; b_.bar = (unsigned*)(as_global(p.k->ws) + OFF_CTL) + CW_BAR; b_.x = xb_xcc_id(); b_.st = (volatile LAS unsigned*)(lds + LDS_MISC + 256); xcd_barrier(b_, p.wv); } while (0)
    run_phase<PH_PREP>(p, 0, lds); WG_SYNC();
    run_phase<PH_MOD>(p, 0, lds); WG_SYNC();
    GRID_BAR();
    run_phase<PH_NORM0>(p, 0, lds);
    GRID_BAR();
#define LAYER(l) do { constexpr int kind = (l) % 3; \
        if constexpr (kind == 0) { run_phase<PH_S5>(p, l, lds); GRID_BAR(); run_phase<PH_GLU>(p, l, lds); GRID_BAR(); } \
        else if constexpr (kind == 1) { run_phase<PH_SCIN>(p, l, lds); GRID_BAR(); run_phase<PH_CONV3>(p, l, lds); GRID_BAR(); run_phase<PH_SCOUT>(p, l, lds); GRID_BAR(); } \
        else { run_phase<PH_PW1>(p, l, lds); GRID_BAR(); run_phase<PH_CONV31>(p, l, lds); GRID_BAR(); run_phase<PH_PW2>(p, l, lds); GRID_BAR(); } \
        run_phase<PH_ROUTE>(p, l, lds); GRID_BAR(); \
        run_phase<PH_MOE1>(p, l, lds); GRID_BAR(); \
        run_phase<PH_MOE2>(p, l, lds); GRID_BAR(); \
        run_phase<PH_COMBINE>(p, l, lds); \
        if constexpr ((l) + 1 < DEPTH) GRID_BAR(); } while (0)
    LAYER(0); LAYER(1); LAYER(2); LAYER(3);
#undef LAYER
#undef GRID_BAR
}
#endif

template <int PH> static void launch(const P& p, int l, int grid, hipStream_t s) {
    static bool attr = false;
    if (!attr) { (void)hipFuncSetAttribute((const void*)k_ph<PH>, hipFuncAttributeMaxDynamicSharedMemorySize, LDS_BYTES); attr = true; }
    hipLaunchKernelGGL(k_ph<PH>, dim3(grid), dim3(NTHR), LDS_BYTES, s, p, l);
}
extern "C" void kernel_launch(void* const* d_in, const int* in_sizes, int n_in, void* d_out, int out_size, void* d_ws, size_t ws_size, hipStream_t stream) {
    if (n_in != N_IN || ws_size < WS_END || out_size != RLAT * D) { fprintf(stderr, "kernel_launch: unexpected problem: n_in %d ws %zu out %d\n", n_in, ws_size, out_size); return; }
    P p{};
    for (int i = 0; i < N_IN; ++i) p.in[i] = (const float*)d_in[i];
    p.out = (float*)d_out; p.ws = (unsigned char*)d_ws;
    (void)hipMemsetAsync((char*)d_ws + OFF_CTL, 0, CTL_BYTES, stream);
#ifndef MK_MULTI
    static int grid = 0;
    if (!grid) {
        int dev = 0, cus = 0, per_cu = 0;
        (void)hipGetDevice(&dev); (void)hipDeviceGetAttribute(&cus, hipDeviceAttributeMultiprocessorCount, dev);
        (void)hipFuncSetAttribute((const void*)fwd, hipFuncAttributeMaxDynamicSharedMemorySize, LDS_BYTES);
        if (hipOccupancyMaxActiveBlocksPerMultiprocessor(&per_cu, (const void*)fwd, NTHR, LDS_BYTES) != hipSuccess || per_cu < 1) fprintf(stderr, "kernel_launch: occupancy query says %d blocks per CU\n", per_cu);
        (void)hipGetLastError();
        grid = cus >= 8 ? (cus & ~7) : 256;
    }
    hipLaunchKernelGGL(fwd, dim3(grid), dim3(NTHR), LDS_BYTES, stream, p);
    return;
#endif
    const int G = 256;
    launch<PH_PREP>(p, 0, G, stream);
    launch<PH_MOD>(p, 0, G, stream);
    launch<PH_NORM0>(p, 0, G, stream);
    for (int l = 0; l < DEPTH; ++l) {
        const int kind = l % 3;
        if (kind == 0) { launch<PH_S5>(p, l, G, stream); launch<PH_GLU>(p, l, G, stream); }
        else if (kind == 1) { launch<PH_SCIN>(p, l, G, stream); launch<PH_CONV3>(p, l, G, stream); launch<PH_SCOUT>(p, l, G, stream); }
        else { launch<PH_PW1>(p, l, G, stream); launch<PH_CONV31>(p, l, G, stream); launch<PH_PW2>(p, l, G, stream); }
        launch<PH_ROUTE>(p, l, G, stream);
        launch<PH_MOE1>(p, l, G, stream);
        launch<PH_MOE2>(p, l, G, stream);
        launch<PH_COMBINE>(p, l, G, stream);
    }
}
```

```cpp
#include <hip/hip_runtime.h>
#include <cstdio>
#include <cstdint>

#define LAS __attribute__((address_space(3)))
typedef unsigned short bf16_t;
typedef short bf16x8 __attribute__((ext_vector_type(8)));
typedef float f32x4 __attribute__((ext_vector_type(4)));
typedef float f32x2 __attribute__((ext_vector_type(2)));
typedef unsigned u32x4 __attribute__((ext_vector_type(4)));
typedef unsigned u32x2 __attribute__((ext_vector_type(2)));

constexpr int D = 1024, NBATCH = 4, SEQ = 4096, NCTX = 256, DEPTH = 4;
constexpr int RCTX = NBATCH * NCTX, RLAT = NBATCH * SEQ, RTOT = RCTX + RLAT;
constexpr int NE = 32, TOPK = 4, CAP = RTOT, MAXMT = 304;
constexpr int NTHR = 512, NWV = 8;
constexpr int LDS_BYTES = 157696, LDS_STAGE = 131072, LDS_MISC = 139264;

enum { I_X = 0, I_C, I_CTX, I_CCTX, I_ADAW, I_ADAB, I_N1G, I_N2G, I_FING, I_LRE, I_LIM, I_LDT, I_BRE, I_BIM, I_CRE, I_CIM, I_S5D, I_GLUW, I_GLUB,
       I_SCWIN, I_SCCW, I_SCWOUT, I_PW1W, I_PW1B, I_DWW, I_DWB, I_LNG, I_LNB, I_PW2W, I_PW2B, I_RW, I_RB, I_WGU, I_BGU, I_WD, I_BD, N_IN };

constexpr size_t MiB = 1u << 20;
constexpr size_t OFF_CTL = 0, CTL_BYTES = 1 * MiB;
constexpr size_t OFF_MOD = 1 * MiB, OFF_GATE = 2 * MiB, OFF_ELIST = 3 * MiB, OFF_BGUP = 6 * MiB, OFF_RWT = 7 * MiB;
constexpr size_t OFF_S5T = 7 * MiB + 512 * 1024;
constexpr size_t OFF_X = 8 * MiB, OFF_HN = 76 * MiB, OFF_A2 = 110 * MiB, OFF_F = 144 * MiB, OFF_Z = 178 * MiB;
constexpr size_t OFF_YF = 280 * MiB, OFF_YB = 348 * MiB, OFF_HM = 416 * MiB, OFF_Y = 568 * MiB;
constexpr size_t OFF_WT = 320 * MiB;
constexpr size_t OFF_KT = 280 * MiB, OFF_GT = 288 * MiB;
constexpr size_t OFF_WGLU = 704 * MiB, OFF_WSCIN = 712 * MiB, OFF_WSCOUT = 718 * MiB, OFF_WPW1 = 720 * MiB, OFF_WPW2 = 724 * MiB;
constexpr size_t OFF_WGU = 728 * MiB, OFF_WD = 1240 * MiB, WS_END = 1496 * MiB;
constexpr int CW_CNT = 64;
constexpr int CW_BAR = 4096;

struct P { const float* in[N_IN]; float* out; unsigned char* ws; };
typedef const __attribute__((address_space(4))) P* KP;
struct Cx { KP k; int wv; };
template <class T> __device__ __forceinline__ T* as_global(T* q) { return (T*)(__attribute__((address_space(1))) T*)q; }

#define WG_SYNC() do { __builtin_amdgcn_fence(__ATOMIC_RELEASE, "workgroup"); __builtin_amdgcn_s_barrier(); __builtin_amdgcn_fence(__ATOMIC_ACQUIRE, "workgroup"); } while (0)
typedef int i32x8 __attribute__((ext_vector_type(8)));
typedef int i32x4 __attribute__((ext_vector_type(4)));
__device__ __forceinline__ float sat8(float x) { return __builtin_fminf(__builtin_fmaxf(x, -448.f), 448.f); }
__device__ __forceinline__ unsigned pk4_fp8(float a, float b, float c, float d) { int r = 0; r = __builtin_amdgcn_cvt_pk_fp8_f32(a, b, r, false); r = __builtin_amdgcn_cvt_pk_fp8_f32(c, d, r, true); return (unsigned)r; }
__device__ __forceinline__ unsigned pk4_fp8_sat(float a, float b, float c, float d) { return pk4_fp8(sat8(a), sat8(b), sat8(c), sat8(d)); }
constexpr float W8_SCALE = 64.f, H8_SCALE = 4.f, Y8_SCALE = 16.f;
__device__ __forceinline__ int opaque_tid(int wv) { unsigned z = 0u; asm volatile("" : "+v"(z)); return wv * 64 + (int)__builtin_amdgcn_mbcnt_hi(~0u, __builtin_amdgcn_mbcnt_lo(~0u, z)); }
__device__ __forceinline__ float bf2f(unsigned b) { return __uint_as_float(b << 16); }
typedef __bf16 bf16x2_t __attribute__((ext_vector_type(2)));
__device__ __forceinline__ unsigned pk2(float lo, float hi) { const f32x2 v = {lo, hi}; return __builtin_bit_cast(unsigned, __builtin_convertvector(v, bf16x2_t)); }
__device__ __forceinline__ float sigm(float x) { return __builtin_amdgcn_rcpf(1.f + __expf(-x)); }
__device__ __forceinline__ float silu(float x) { return x * sigm(x); }
__device__ __forceinline__ float gelu_tanh(float x) { return x * sigm(1.5957691216f * (x + 0.044715f * x * x * x)); }
__device__ __forceinline__ float wave_sum(float v) {
#pragma unroll
    for (int o = 1; o < 64; o <<= 1) v += __shfl_xor(v, o);
    return v;
}
__device__ __forceinline__ int row_bi(int row) { return row < RCTX ? 4 : ((row - RCTX) >> 12); }
__device__ __forceinline__ void load_row(const float* r, int lane, f32x4 (&v)[4]) {
#pragma unroll
    for (int j = 0; j < 4; ++j) v[j] = *(const f32x4*)(r + 256 * j + 4 * lane);
}
__device__ __forceinline__ float row_sumsq(const f32x4 (&v)[4]) {
    float s = 0.f;
#pragma unroll
    for (int j = 0; j < 4; ++j) s += (v[j].x * v[j].x + v[j].y * v[j].y) + (v[j].z * v[j].z + v[j].w * v[j].w);
    return wave_sum(s);
}
__device__ __forceinline__ void norm_mod(const f32x4 (&v)[4], float rs, const float* g, const float* sc, const float* sh, int lane, f32x4 (&o)[4]) {
#pragma unroll
    for (int j = 0; j < 4; ++j) { const int col = 256 * j + 4 * lane;
        const f32x4 gg = *(const f32x4*)(g + col), s = *(const f32x4*)(sc + col), h = *(const f32x4*)(sh + col);
        o[j] = v[j] * rs * gg * (1.f + s) + h; }
}
__device__ __forceinline__ void store_row_bf16(bf16_t* dst, int lane, const f32x4 (&o)[4]) {
#pragma unroll
    for (int j = 0; j < 4; ++j) { u32x2 w; w.x = pk2(o[j].x, o[j].y); w.y = pk2(o[j].z, o[j].w); *(u32x2*)(dst + 256 * j + 4 * lane) = w; }
}
__device__ __forceinline__ void store_row_fp8(unsigned char* dst, int lane, const f32x4 (&o)[4]) {
#pragma unroll
    for (int j = 0; j < 4; ++j) *(unsigned*)(dst + 256 * j + 4 * lane) = pk4_fp8_sat(o[j].x, o[j].y, o[j].z, o[j].w);
}
__device__ __forceinline__ void store_row_s5(bf16_t* HNs, int row, int lane, const f32x4 (&o)[4]) {
    const int b = row < RCTX ? row >> 8 : (row - RCTX) >> 12, tok = row < RCTX ? row & 255 : NCTX + ((row - RCTX) & 4095);
#pragma unroll
    for (int j = 0; j < 4; ++j) { u32x2 w; w.x = pk2(o[j].x, o[j].y); w.y = pk2(o[j].z, o[j].w);
        *(u32x2*)(HNs + ((size_t)(b * 64 + 16 * j + (lane >> 2)) * (NCTX + SEQ) + tok) * 16 + (lane & 3) * 4) = w; }
}
__device__ __forceinline__ f32x4 ld_bf16x4(const bf16_t* p) { const u32x2 w = *(const u32x2*)p; return (f32x4){bf2f(w.x & 0xffffu), bf2f(w.x >> 16), bf2f(w.y & 0xffffu), bf2f(w.y >> 16)}; }
__device__ __forceinline__ void load_row_bf16(const bf16_t* r, int lane, f32x4 (&v)[4]) {
#pragma unroll
    for (int j = 0; j < 4; ++j) v[j] = ld_bf16x4(r + 256 * j + 4 * lane);
}


#define XB_TMO      128
#define XB_XCNT(j)  (256  + 64 * (j))
#define XB_XSUB(j)  (1280 + 64 * (j))
#define XB_XGEN(j)  (2304 + 64 * (j))
#define XB_TOP      3328
#define XB_TOPGEN   3392
#define XCD_BAR_WORDS 3456
#define XB_SPIN_CAP (1u << 18)

typedef __attribute__((address_space(1))) unsigned gu32;
__device__ __forceinline__ unsigned xb_ld(unsigned* p)              { return __hip_atomic_load((gu32*)p, __ATOMIC_RELAXED, __HIP_MEMORY_SCOPE_AGENT); }
__device__ __forceinline__ unsigned xb_add(unsigned* p, unsigned v) { return __hip_atomic_fetch_add((gu32*)p, v, __ATOMIC_RELAXED, __HIP_MEMORY_SCOPE_AGENT); }
__device__ __forceinline__ unsigned xb_xcc_id() { return (unsigned)__builtin_amdgcn_s_getreg((3 << 11) | 20) & 0xFu; }
#define XB_SPIN(cond, bar) do { unsigned _sp = 0; while (cond) { __builtin_amdgcn_s_sleep(1); \
    if ((++_sp & 255u) == 0u) { if (xb_ld(&(bar)[XB_TMO])) break; if (_sp > XB_SPIN_CAP) { xb_add(&(bar)[XB_TMO], 1u); break; } } } } while (0)

struct XcdBarrier {
    unsigned* bar; unsigned x;
    volatile LAS unsigned* st;
};
__device__ __forceinline__ XcdBarrier xcd_barrier_post(unsigned* bar, volatile LAS unsigned* st) {
    XcdBarrier b; b.bar = bar; b.x = xb_xcc_id(); b.st = st;
    if (threadIdx.x == 0) (void)xb_add(&as_global(bar)[XB_XCNT(b.x)], 1u);
    return b;
}
__device__ __forceinline__ void xcd_barrier_complete(unsigned* bar, unsigned x, unsigned& nloc, unsigned& nx) {
    const unsigned G = gridDim.x * gridDim.y * gridDim.z;
    unsigned sum, cnt, mine, sp = 0u;
    for (;;) {
        sum = 0u; cnt = 0u; mine = 0u;
#pragma unroll
        for (unsigned j = 0; j < 16; ++j) { const unsigned c = xb_ld(&bar[XB_XCNT(j)]); sum += c; cnt += (c > 0u) ? 1u : 0u; mine = (j == x) ? c : mine; }
        if (sum == G) break;
        __builtin_amdgcn_s_sleep(1);
        if ((++sp & 255u) == 0u) { if (xb_ld(&bar[XB_TMO])) break; if (sp > XB_SPIN_CAP) { xb_add(&bar[XB_TMO], 1u); break; } }
    }
    nloc = mine > 0u ? mine : 1u; nx = cnt > 0u ? cnt : 1u;
}
__device__ __forceinline__ void xcd_barrier(const XcdBarrier& b, int wv) {
    asm volatile("s_waitcnt vmcnt(0)" ::: "memory");
    WG_SYNC();
    if (opaque_tid(wv) == 0) {
        unsigned* bar = b.bar; asm volatile("" : "+s"(bar)); bar = as_global(bar);
        __builtin_amdgcn_s_waitcnt(0);
        unsigned nloc = b.st[0], nx = b.st[1];
        if (nloc == 0u) { xcd_barrier_complete(bar, b.x, nloc, nx); b.st[0] = nloc; b.st[1] = nx; }
        const unsigned old = xb_add(&bar[XB_XSUB(b.x)], 1u);
        const unsigned gen = old / nloc;
        if (old + 1u == (gen + 1u) * nloc) {
            __builtin_amdgcn_fence(__ATOMIC_RELEASE, "agent");
            asm volatile("s_waitcnt vmcnt(0)" ::: "memory");
            const unsigned og = xb_add(&bar[XB_TOP], 1u);
            const unsigned tg = og / nx;
            if (og + 1u == (tg + 1u) * nx) xb_add(&bar[XB_TOPGEN], 1u);
            else XB_SPIN(xb_ld(&bar[XB_TOPGEN]) == tg, bar);
            __builtin_amdgcn_fence(__ATOMIC_ACQUIRE, "agent");
            xb_add(&bar[XB_XGEN(b.x)], 1u);
            asm volatile("s_waitcnt vmcnt(0)" ::: "memory");
        } else {
            XB_SPIN(xb_ld(&bar[XB_XGEN(b.x)]) == gen, bar);
            __builtin_amdgcn_fence(__ATOMIC_ACQUIRE, "agent");
            asm volatile("s_waitcnt vmcnt(0)" ::: "memory");
        }
    }
    WG_SYNC();
}

__device__ __forceinline__ int tr_dst(int mode, int cb, int n) {
    if (mode == 0) return cb * 64 + n;
    if (mode == 3) {
        if (cb < 16) return 256 * (cb >> 1) + 64 * (cb & 1) + n;
        if (cb < 32) return 2048 + 64 * (cb - 16) + n;
        return 256 * ((cb - 32) >> 1) + 128 + 64 * (cb & 1) + n; }
    const int j0 = cb * 32, pn = j0 >> 7, jo = j0 & 127;
    if (mode == 1) return 256 * pn + 128 * (n >> 5) + jo + (n & 31);
    return 256 * pn + 128 * (n & 1) + jo + (n >> 1);
}
__device__ __forceinline__ int tr_src(int mode, int cb, int n, int N) {
    if (mode == 0) return cb * 64 + n;
    if (mode == 1) return (n >> 5) * (N >> 1) + cb * 32 + (n & 31);
    return cb * 64 + n;
}
__device__ __forceinline__ void tr_item(const float* W, int N, bf16_t* WT, int mode, int kb, int cb, LAS float* scr, int lane) {
    const int k0 = kb * 64; const int src = tr_src(mode, cb, lane, N);
#pragma unroll 16
    for (int kk = 0; kk < 64; ++kk) scr[kk * 65 + lane] = __builtin_nontemporal_load(W + (size_t)(k0 + kk) * N + src);
    asm volatile("s_waitcnt lgkmcnt(0)" ::: "memory");
    const int c = lane & 7;
#pragma unroll
    for (int j = 0; j < 8; ++j) { const int n = (lane >> 3) + 8 * j; const LAS float* s = scr + (8 * c) * 65 + n;
        u32x4 o; o.x = pk2(s[0], s[65]); o.y = pk2(s[2 * 65], s[3 * 65]); o.z = pk2(s[4 * 65], s[5 * 65]); o.w = pk2(s[6 * 65], s[7 * 65]);
        *(u32x4*)(WT + (size_t)tr_dst(mode, cb, n) * 1024 + k0 + 8 * c) = o; }
    asm volatile("s_waitcnt lgkmcnt(0)" ::: "memory");
}
__device__ __forceinline__ void tr_item8(const float* W, int N, unsigned char* WT, int mode, int kb, int cb, LAS float* scr, int lane) {
    const int k0 = kb * 64; const int src = tr_src(mode, cb, lane, N);
#pragma unroll 16
    for (int kk = 0; kk < 64; ++kk) scr[kk * 65 + lane] = __builtin_nontemporal_load(W + (size_t)(k0 + kk) * N + src);
    asm volatile("s_waitcnt lgkmcnt(0)" ::: "memory");
    const int c = lane & 3;
#pragma unroll
    for (int j = 0; j < 4; ++j) { const int n = (lane >> 2) + 16 * j; const LAS float* s = scr + (16 * c) * 65 + n;
        u32x4 o;
        o.x = pk4_fp8(s[0] * W8_SCALE, s[65] * W8_SCALE, s[2 * 65] * W8_SCALE, s[3 * 65] * W8_SCALE); o.y = pk4_fp8(s[4 * 65] * W8_SCALE, s[5 * 65] * W8_SCALE, s[6 * 65] * W8_SCALE, s[7 * 65] * W8_SCALE);
        o.z = pk4_fp8(s[8 * 65] * W8_SCALE, s[9 * 65] * W8_SCALE, s[10 * 65] * W8_SCALE, s[11 * 65] * W8_SCALE); o.w = pk4_fp8(s[12 * 65] * W8_SCALE, s[13 * 65] * W8_SCALE, s[14 * 65] * W8_SCALE, s[15 * 65] * W8_SCALE);
        *(u32x4*)(WT + (size_t)tr_dst(mode, cb, n) * 1024 + k0 + 16 * c) = o; }
    asm volatile("s_waitcnt lgkmcnt(0)" ::: "memory");
}
constexpr int MOE_ITEMS_GU = NE * 16 * 32, MOE_ITEMS = MOE_ITEMS_GU + NE * 16 * 16;
__device__ __forceinline__ void conv_moe_item(const Cx& p, int l, int I, LAS float* scr, int lane) {
    if (I < MOE_ITEMS_GU) { const int e = I >> 9, rr = I & 511, kb = rr >> 5, cb = rr & 31;
        tr_item8(as_global(p.k->in[I_WGU]) + (size_t)(l * NE + e) * 1024 * 2048, 2048, as_global(p.k->ws) + OFF_WGU + (size_t)(l * NE + e) * 2 * MiB, 2, kb, cb, scr, lane); }
    else { const int J = I - MOE_ITEMS_GU, e = J >> 8, rr = J & 255, kb = rr >> 4, cb = rr & 15;
        tr_item8(as_global(p.k->in[I_WD]) + (size_t)(l * NE + e) * 1024 * 1024, 1024, as_global(p.k->ws) + OFF_WD + (size_t)(l * NE + e) * 1 * MiB, 0, kb, cb, scr, lane); }
}
constexpr int TAIL_Q = 3;
__device__ __forceinline__ int tail_cap(int total, int G) { const int rounds = (total + G - 1) / G, rem = total - (rounds - 1) * G; return rem == G ? 0 : (G - rem) * NWV * TAIL_Q; }
__device__ __forceinline__ void tail_convert(const Cx& p, LAS unsigned char* lds, int lnext, int base, int total) {
    const int G = gridDim.x, c = blockIdx.x, rounds = (total + G - 1) / G, rem = total - (rounds - 1) * G;
    if (rem == G || c < rem) return;
    const int tid = opaque_tid(p.wv), lane = tid & 63, wave = p.wv; LAS float* scr = (LAS float*)(lds + wave * 16640);
    const int i0 = base + ((c - rem) * NWV + wave) * TAIL_Q;
#pragma unroll 1
    for (int k = 0; k < TAIL_Q; ++k) if (i0 + k < MOE_ITEMS) conv_moe_item(p, lnext, i0 + k, scr, lane);
}
__device__ __forceinline__ void conv_catchup(const Cx& p, LAS unsigned char* lds, int l, int covered) {
    const int tid = opaque_tid(p.wv), lane = tid & 63, wave = p.wv; LAS float* scr = (LAS float*)(lds + wave * 16640);
    for (int I = covered + blockIdx.x * NWV + wave; I < MOE_ITEMS; I += gridDim.x * NWV) conv_moe_item(p, l, I, scr, lane);
    WG_SYNC();
}
__device__ __forceinline__ void ph_prep(const Cx& p, LAS unsigned char* lds) {
    const int tid = opaque_tid(p.wv), lane = tid & 63, wave = tid >> 6;
    LAS float* scr = (LAS float*)(lds + wave * 16640);
    const int gw = blockIdx.x * NWV + wave, NGW = gridDim.x * NWV;
    constexpr int NJ = 7;
    const int jsrc[NJ] = {I_WGU, I_WD, I_GLUW, I_SCWIN, I_SCWOUT, I_PW1W, I_PW2W};
    const int jN[NJ] = {2048, 1024, 2048, 3072, 1024, 2048, 1024};
    const int jmode[NJ] = {2, 0, 1, 3, 0, 1, 0};
    const int jnmat[NJ] = {128, 128, 2, 1, 1, 1, 1};
    const size_t joff[NJ] = {OFF_WGU, OFF_WD, OFF_WGLU, OFF_WSCIN, OFF_WSCOUT, OFF_WPW1, OFF_WPW2};
    { LAS float* pw = (LAS float*)lds;
      LAS float* ql = pw + 4224; LAS float* cl = pw + 4352; LAS float* bl = pw + 6400;
      for (int item = blockIdx.x; item < 2 * 2 * 64; item += gridDim.x) {
          const int jd = item >> 6, g = item & 63, jj = jd >> 1, d = jd & 1;
          WG_SYNC();
          { const int n = tid & 63, eg = tid >> 6, i = (jd * 64 + g) * 64 + n; const float lre = as_global(p.k->in[I_LRE])[i], lim = as_global(p.k->in[I_LIM])[i], dt = __expf(as_global(p.k->in[I_LDT])[i >> 6]);
#pragma unroll 1
            for (int e = eg; e <= 32; e += 8) { const float er = expf(lre * dt * (float)e), ang = lim * dt * (float)e; pw[(e * 64 + n) * 2] = er * cosf(ang); pw[(e * 64 + n) * 2 + 1] = er * sinf(ang); }
            if (eg == 1) { const float er = expf(lre * dt), nr = er * cosf(lim * dt) - 1.f, ni = er * sinf(lim * dt), den = 1.f / (lre * lre + lim * lim);
                ql[n * 2] = (nr * lre + ni * lim) * den; ql[n * 2 + 1] = (ni * lre - nr * lim) * den; }
            const size_t cb0 = (size_t)(jd * 64 + g) * 1024;
#pragma unroll
            for (int q = 0; q < 2; ++q) { const int idx = tid + NTHR * q; cl[idx * 2] = as_global(p.k->in[I_CRE])[cb0 + idx]; cl[idx * 2 + 1] = as_global(p.k->in[I_CIM])[cb0 + idx];
                bl[idx * 2] = as_global(p.k->in[I_BRE])[cb0 + idx]; bl[idx * 2 + 1] = as_global(p.k->in[I_BIM])[cb0 + idx]; } }
          WG_SYNC();
          { const int pair = tid & 255, hq = pair >> 4, hp = pair & 15, lh = tid >> 8;
            unsigned short* kt = (unsigned short*)(as_global(p.k->ws) + OFF_KT + (size_t)((jj * 64 + g) * 2 + d) * 16896);
            float sacc[16];
#pragma unroll
            for (int q = 0; q < 16; ++q) sacc[q] = 0.f;
            if (lh == 0) kt[pair] = 0;
#pragma unroll 2
            for (int n = 0; n < 64; ++n) { const float qr = ql[n * 2], qi = ql[n * 2 + 1], br = bl[(n * 16 + hp) * 2], bi = bl[(n * 16 + hp) * 2 + 1], cr = cl[(hq * 64 + n) * 2], ci = cl[(hq * 64 + n) * 2 + 1];
                const float bbr = qr * br - qi * bi, bbi = qr * bi + qi * br, cbr = cr * bbr - ci * bbi, cbi = cr * bbi + ci * bbr;
#pragma unroll
                for (int q = 0; q < 16; ++q) { const int lg = 16 * lh + q; sacc[q] += cbr * pw[(lg * 64 + n) * 2] - cbi * pw[(lg * 64 + n) * 2 + 1]; } }
#pragma unroll
            for (int q = 0; q < 16; ++q) kt[(16 * lh + q + 1) * 256 + pair] = (unsigned short)(pk2(sacc[q], 0.f) & 0xffffu); }
          { const int t = tid >> 4, hq = tid & 15, e = d == 0 ? t + 1 : 32 - t, m = t >> 1, ii = (t & 1) * 16 + hq;
            unsigned char* gt = as_global(p.k->ws) + OFF_GT + (size_t)((jj * 64 + g) * 2 + d) * 131072;
#pragma unroll 4
            for (int n = 0; n < 64; ++n) { const float pr = pw[(e * 64 + n) * 2], pi = pw[(e * 64 + n) * 2 + 1], cr = cl[(hq * 64 + n) * 2], ci = cl[(hq * 64 + n) * 2 + 1];
                *(unsigned*)(gt + ((m * 8 + (n >> 3)) * 64 + ((n >> 2) & 1) * 32 + ii) * 16 + (n & 3) * 4) = pk2(cr * pr - ci * pi, -(cr * pi + ci * pr)); } }
          { const int ig = tid & 127, mt = ig >> 5, ii = ig & 31, st = 16 * mt + (ii >> 1), ri = ii & 1, hf = (tid >> 7) & 1, sg = tid >> 8;
            unsigned char* wt = as_global(p.k->ws) + OFF_WT + (size_t)((jj * 64 + g) * 2 + d) * 131072;
            const float qr = ql[st * 2], qi = ql[st * 2 + 1]; float bbr[8], bbi[8];
#pragma unroll
            for (int c = 0; c < 8; ++c) { const float br = bl[(st * 16 + 8 * hf + c) * 2], bi = bl[(st * 16 + 8 * hf + c) * 2 + 1]; bbr[c] = qr * br - qi * bi; bbi[c] = qr * bi + qi * br; }
#pragma unroll 2
            for (int s = 16 * sg; s < 16 * sg + 16; ++s) { const int e = d == 0 ? 31 - s : s; const float pr = pw[(e * 64 + st) * 2], pi = pw[(e * 64 + st) * 2 + 1]; float v[8];
#pragma unroll
                for (int c = 0; c < 8; ++c) v[c] = ri ? pr * bbi[c] + pi * bbr[c] : pr * bbr[c] - pi * bbi[c];
                u32x4 o; o.x = pk2(v[0], v[1]); o.y = pk2(v[2], v[3]); o.z = pk2(v[4], v[5]); o.w = pk2(v[6], v[7]);
                *(u32x4*)(wt + ((mt * 32 + s) * 64 + hf * 32 + ii) * 16) = o; } }
      }
      WG_SYNC(); }
    int base = 0;
#pragma unroll
    for (int j = 2; j < NJ; ++j) {
        const int N = jN[j], ncb = N / 64, ipm = 16 * ncb, tot = ipm * jnmat[j];
        const float* W0 = as_global(p.k->in[jsrc[j]]); bf16_t* T0 = (bf16_t*)(as_global(p.k->ws) + joff[j]);
        int first = gw - (base % NGW); if (first < 0) first += NGW;
        for (int it = first; it < tot; it += NGW) { const int mat = it / ipm, rr = it % ipm, kb = rr / ncb, cb = rr % ncb;
            if (j != 3) tr_item8(W0 + (size_t)mat * 1024 * N, N, (unsigned char*)T0 + (size_t)mat * N * 1024, jmode[j], kb, cb, scr, lane);
            else tr_item(W0 + (size_t)mat * 1024 * N, N, T0 + (size_t)mat * N * 1024, jmode[j], kb, cb, scr, lane); }
        base += tot;
    }
    { int first = gw - (base % NGW); if (first < 0) first += NGW;
      for (int I = first; I < MOE_ITEMS; I += NGW) conv_moe_item(p, 0, I, scr, lane); }
    { f32x4* tb = (f32x4*)(as_global(p.k->ws) + OFF_S5T);
      for (int i = blockIdx.x * NTHR + tid; i < 4 * 64 * 64; i += gridDim.x * NTHR) {
          const float lre = as_global(p.k->in[I_LRE])[i], lim = as_global(p.k->in[I_LIM])[i], dt = __expf(as_global(p.k->in[I_LDT])[i >> 6]);
          const float er = expf(lre * dt), lbr = er * cosf(lim * dt), lbi = er * sinf(lim * dt);
          const float nr = lbr - 1.f, ni = lbi, den = 1.f / (lre * lre + lim * lim);
          tb[i] = (f32x4){lbr, lbi, (nr * lre + ni * lim) * den, (ni * lre - nr * lim) * den}; } }
    { const float* rw = as_global(p.k->in[I_RW]); bf16_t* rt = (bf16_t*)(as_global(p.k->ws) + OFF_RWT);
      for (int i = blockIdx.x * NTHR + tid; i < DEPTH * NE * D; i += gridDim.x * NTHR) { const int k = i & 1023, e = (i >> 10) & 31, l = i >> 15;
          rt[i] = (bf16_t)(pk2(rw[((size_t)l * D + k) * NE + e], 0.f) & 0xffffu); } }
    { const float* bgu = as_global(p.k->in[I_BGU]); float* bp = (float*)(as_global(p.k->ws) + OFF_BGUP);
      for (int i = blockIdx.x * NTHR + tid; i < DEPTH * NE * 2048; i += gridDim.x * NTHR) {
          const int n = i & 2047, m = i >> 11, pn = n >> 8, s = (n >> 7) & 1, jj = n & 127;
          bp[i] = bgu[(size_t)m * 2048 + 2 * (128 * pn + jj) + s]; } }
}
__device__ __forceinline__ void ph_mod(const Cx& p, LAS unsigned char* lds) {
    const int tid = opaque_tid(p.wv), lane = tid & 63, wave = tid >> 6;
    LAS float* sc = (LAS float*)lds; LAS float* red = sc + 5 * 1024;
    for (int i = tid; i < 5 * 1024; i += NTHR) { const int bi = i >> 10, k = i & 1023; const float v = bi < 4 ? as_global(p.k->in[I_C])[bi * 1024 + k] : as_global(p.k->in[I_CCTX])[k]; sc[i] = silu(v); }
    WG_SYNC();
    float* mod = (float*)(as_global(p.k->ws) + OFF_MOD);
    for (int item = blockIdx.x; item < DEPTH * 48; item += gridDim.x) {
        const int l = item / 48, n0 = (item % 48) * 128;
        const float* W = as_global(p.k->in[I_ADAW]) + (size_t)l * 1024 * 6144 + n0 + lane * 2;
        float a[5][2];
#pragma unroll
        for (int b = 0; b < 5; ++b) { a[b][0] = 0.f; a[b][1] = 0.f; }
#pragma unroll 16
        for (int k = wave * 128; k < wave * 128 + 128; ++k) { const f32x2 w = __builtin_nontemporal_load((const f32x2*)(W + (size_t)k * 6144));
#pragma unroll
            for (int b = 0; b < 5; ++b) { const float s = sc[b * 1024 + k]; a[b][0] += s * w.x; a[b][1] += s * w.y; } }
#pragma unroll
        for (int b = 0; b < 5; ++b) { red[(wave * 5 + b) * 128 + lane * 2] = a[b][0]; red[(wave * 5 + b) * 128 + lane * 2 + 1] = a[b][1]; }
        WG_SYNC();
        for (int o = tid; o < 640; o += NTHR) { const int b = o >> 7, col = o & 127; float s = as_global(p.k->in[I_ADAB])[l * 6144 + n0 + col];
#pragma unroll
            for (int w = 0; w < 8; ++w) s += red[(w * 5 + b) * 128 + col];
            mod[(size_t)(l * 5 + b) * 6144 + n0 + col] = s; }
        WG_SYNC();
    }
}
__device__ __forceinline__ void ph_norm_first(const Cx& p) {
    const int tid = opaque_tid(p.wv), lane = tid & 63, wave = tid >> 6;
    bf16_t* X = (bf16_t*)(as_global(p.k->ws) + OFF_X); bf16_t* HN = (bf16_t*)(as_global(p.k->ws) + OFF_HN); const float* mod = (const float*)(as_global(p.k->ws) + OFF_MOD);
    for (int row = blockIdx.x * NWV + wave; row < RTOT; row += gridDim.x * NWV) {
        const float* src = row < RCTX ? as_global(p.k->in[I_CTX]) + (size_t)row * D : as_global(p.k->in[I_X]) + (size_t)(row - RCTX) * D;
        f32x4 v[4], o[4];
#pragma unroll
        for (int j = 0; j < 4; ++j) v[j] = __builtin_nontemporal_load((const f32x4*)(src + 256 * j + 4 * lane));
        store_row_bf16(X + (size_t)row * D, lane, v);
        const float rs = rsqrtf(row_sumsq(v) * (1.f / D) + 1e-6f);
        const float* m = mod + (size_t)(0 * 5 + row_bi(row)) * 6144;
        norm_mod(v, rs, as_global(p.k->in[I_N1G]), m + 1024, m, lane, o);
        store_row_s5(HN, row, lane, o);
    }
}

namespace g8 {
constexpr int BM = 256, BK = 64, HALF = 128, HTB = HALF * BK * 2;
__host__ __device__ __forceinline__ int lds_byte(int r, int c) { const int st = (r >> 4) * 2 + (c >> 5), rr = r & 15, cc = c & 31, ob = rr * 64 + cc * 2; return st * 1024 + (ob ^ (((ob >> 9) & 1) << 5)); }
__host__ __device__ __forceinline__ void stage_rc(int b, int& R, int& C) { const int st = b / 1024, sb = b % 1024, swz = sb ^ (((sb >> 9) & 1) << 5); R = (st >> 1) * 16 + swz / 64; C = (st & 1) * 32 + (swz % 64) / 2; }
__host__ __device__ __forceinline__ int perm32(int rho) { const int n = rho >> 4, i = rho & 15; return 8 * (i >> 2) + 4 * n + (i & 3); }

struct Unit { const char* B; int row0, pn, e, nvalid, lbase, bi, ui, rot; };
constexpr int MOE_TAB_UNITS = 14, MOE_MAX_UNITS = 16;
__device__ __forceinline__ KP fresh(KP k) { asm volatile("" : "+s"(k)); return k; }

template <int RB> struct SchedDenseT {
    KP k; size_t woff; int row_lo, nM, nN, G, c;
    __device__ __forceinline__ bool next(int i, Unit& u) const {
        const int L = i * G + c; if (L >= nM * nN) return false;
        const int pm = L / nN, pn = L % nN;
        u.B = (const char*)(as_global(fresh(k)->ws) + woff) + (size_t)pn * 256 * RB; u.row0 = row_lo + pm * 256; u.pn = pn; u.e = 0; u.nvalid = 256; u.lbase = 0; u.bi = row_bi(u.row0); u.ui = i; u.rot = 0; return true;
    }
    __device__ __forceinline__ unsigned aoff(const Unit& u, int, int r, int C) const { return (unsigned)(u.row0 + r) * (unsigned)RB + (unsigned)C * 2u; }
    static constexpr int ROWB = RB;
};
typedef SchedDenseT<2048> SchedDense;
typedef SchedDenseT<1024> SchedDense8;
struct SchedMoe {
    KP k; size_t woff, estride; const LAS int* desc; const LAS int* tab; int nu; bool gather;
    __device__ __forceinline__ bool next(int i, Unit& u) const {
        if (i >= nu) return false;
        const int e = __builtin_amdgcn_readfirstlane(desc[4 * i]), mg = __builtin_amdgcn_readfirstlane(desc[4 * i + 1]), nv = __builtin_amdgcn_readfirstlane(desc[4 * i + 2]), pr = __builtin_amdgcn_readfirstlane(desc[4 * i + 3]), pn = pr & 0xff;
        u.rot = pr >> 8; u.B = (const char*)(as_global(fresh(k)->ws) + woff) + (size_t)e * estride + (size_t)pn * 256 * ROWB; u.row0 = mg * 256; u.pn = pn; u.e = e; u.nvalid = nv & 0xffff; u.lbase = e * CAP + (nv >> 16) * 256; u.bi = 0; u.ui = i; return true;
    }
    __device__ __forceinline__ unsigned aoff(const Unit& u, int ui, int r, int C) const {
        if (gather) return (unsigned)tab[ui * 256 + r] + (unsigned)C * 2u;
        return (unsigned)(u.row0 + r) * (unsigned)ROWB + (unsigned)C * 2u;
    }
    static constexpr int ROWB = 1024;
};

struct EpiGluRes {
    static constexpr int PERM = 1;
    KP k; int l;
    __device__ __forceinline__ void operator()(const f32x4 (&acc)[2][2][4][2], const Unit& u, int wr, int wc, int fr, int fq) const {
        const KP kk = fresh(k); bf16_t* X = (bf16_t*)(as_global(kk->ws) + OFF_X); const float* bias = as_global(kk->in[I_GLUB]) + (l / 3) * 2048;
        const int j0 = u.pn * 128 + wc * 32 + 8 * fq; const float* g1 = (const float*)(as_global(kk->ws) + OFF_MOD) + (size_t)(l * 5 + u.bi) * 6144 + 2048;
        f32x4 ba[2], bg[2], gg[2];
#pragma unroll
        for (int n = 0; n < 2; ++n) { ba[n] = *(const f32x4*)(bias + j0 + 4 * n); bg[n] = *(const f32x4*)(bias + 1024 + j0 + 4 * n); gg[n] = *(const f32x4*)(g1 + j0 + 4 * n); }
#pragma unroll
        for (int ai = 0; ai < 2; ++ai)
#pragma unroll
            for (int m = 0; m < 4; ++m) { bf16_t* xp = X + (size_t)(u.row0 + ai * 128 + wr * 64 + m * 16 + fr) * D + j0;
                const u32x4 xw = *(const u32x4*)xp; const unsigned xs[4] = {xw.x, xw.y, xw.z, xw.w}; unsigned os[4];
#pragma unroll
                for (int n = 0; n < 2; ++n) { const f32x4 a = acc[ai][0][m][n] * (1.f / W8_SCALE) + ba[n], g = acc[ai][1][m][n] * (1.f / W8_SCALE) + bg[n];
                    f32x4 x = (f32x4){bf2f(xs[2 * n] & 0xffffu), bf2f(xs[2 * n] >> 16), bf2f(xs[2 * n + 1] & 0xffffu), bf2f(xs[2 * n + 1] >> 16)};
                    x.x += gg[n].x * a.x * sigm(g.x); x.y += gg[n].y * a.y * sigm(g.y); x.z += gg[n].z * a.z * sigm(g.z); x.w += gg[n].w * a.w * sigm(g.w);
                    os[2 * n] = pk2(x.x, x.y); os[2 * n + 1] = pk2(x.z, x.w); }
                *(u32x4*)xp = (u32x4){os[0], os[1], os[2], os[3]}; }
    }
};
struct EpiRes {
    static constexpr int PERM = 1;
    KP k; int l, bias_idx;
    __device__ __forceinline__ void operator()(const f32x4 (&acc)[2][2][4][2], const Unit& u, int wr, int wc, int fr, int fq) const {
        const KP kk = fresh(k); bf16_t* X = (bf16_t*)(as_global(kk->ws) + OFF_X); const float* bias = bias_idx >= 0 ? as_global(kk->in[bias_idx]) : nullptr;
        const int c0 = u.pn * 256 + wc * 32 + 8 * fq; const float* g1 = (const float*)(as_global(kk->ws) + OFF_MOD) + (size_t)(l * 5 + u.bi) * 6144 + 2048;
        f32x4 bv[2][2], gg[2][2];
#pragma unroll
        for (int bj = 0; bj < 2; ++bj)
#pragma unroll
            for (int n = 0; n < 2; ++n) { const int c = c0 + 128 * bj + 4 * n; bv[bj][n] = bias ? *(const f32x4*)(bias + c) : (f32x4){0.f, 0.f, 0.f, 0.f}; gg[bj][n] = *(const f32x4*)(g1 + c); }
#pragma unroll
        for (int ai = 0; ai < 2; ++ai)
#pragma unroll
            for (int m = 0; m < 4; ++m) { bf16_t* xp = X + (size_t)(u.row0 + ai * 128 + wr * 64 + m * 16 + fr) * D + c0;
#pragma unroll
                for (int bj = 0; bj < 2; ++bj) { const u32x4 xw = *(const u32x4*)(xp + 128 * bj); const unsigned xs[4] = {xw.x, xw.y, xw.z, xw.w}; unsigned os[4];
#pragma unroll
                    for (int n = 0; n < 2; ++n) { f32x4 x = (f32x4){bf2f(xs[2 * n] & 0xffffu), bf2f(xs[2 * n] >> 16), bf2f(xs[2 * n + 1] & 0xffffu), bf2f(xs[2 * n + 1] >> 16)};
                        x += gg[bj][n] * (acc[ai][bj][m][n] * (1.f / W8_SCALE) + bv[bj][n]); os[2 * n] = pk2(x.x, x.y); os[2 * n + 1] = pk2(x.z, x.w); }
                    *(u32x4*)(xp + 128 * bj) = (u32x4){os[0], os[1], os[2], os[3]}; } }
    }
};
struct EpiBf16 {
    static constexpr int PERM = 1;
    KP k; size_t ooff; int ldc; float dq;
    __device__ __forceinline__ void operator()(const f32x4 (&acc)[2][2][4][2], const Unit& u, int wr, int wc, int fr, int fq) const {
        bf16_t* O = (bf16_t*)(as_global(fresh(k)->ws) + ooff);
        const int c0 = u.pn * 256 + wc * 32 + 8 * fq;
#pragma unroll
        for (int ai = 0; ai < 2; ++ai)
#pragma unroll
            for (int m = 0; m < 4; ++m) { bf16_t* op = O + (size_t)(u.row0 + ai * 128 + wr * 64 + m * 16 + fr) * ldc + c0;
#pragma unroll
                for (int bj = 0; bj < 2; ++bj) { const f32x4 v0 = acc[ai][bj][m][0] * dq, v1 = acc[ai][bj][m][1] * dq;
                    u32x4 w; w.x = pk2(v0.x, v0.y); w.y = pk2(v0.z, v0.w); w.z = pk2(v1.x, v1.y); w.w = pk2(v1.z, v1.w); *(u32x4*)(op + 128 * bj) = w; } }
    }
};
struct EpiScin {
    static constexpr int PERM = 1;
    KP k;
    __device__ __forceinline__ void operator()(const f32x4 (&acc)[2][2][4][2], const Unit& u, int wr, int wc, int fr, int fq) const {
        bf16_t* O = (bf16_t*)(as_global(fresh(k)->ws) + OFF_Z);
        if (u.pn < 8) { const int j0 = u.pn * 128 + wc * 32 + 8 * fq;
#pragma unroll
            for (int ai = 0; ai < 2; ++ai)
#pragma unroll
                for (int m = 0; m < 4; ++m) { const f32x4 p0 = acc[ai][0][m][0] * acc[ai][1][m][0], p1 = acc[ai][0][m][1] * acc[ai][1][m][1];
                    u32x4 w; w.x = pk2(p0.x, p0.y); w.y = pk2(p0.z, p0.w); w.z = pk2(p1.x, p1.y); w.w = pk2(p1.z, p1.w);
                    *(u32x4*)(O + (size_t)(u.row0 + ai * 128 + wr * 64 + m * 16 + fr) * 2048 + j0) = w; }
        } else { const int c0 = 1024 + (u.pn - 8) * 256 + wc * 32 + 8 * fq;
#pragma unroll
            for (int ai = 0; ai < 2; ++ai)
#pragma unroll
                for (int m = 0; m < 4; ++m) { bf16_t* op = O + (size_t)(u.row0 + ai * 128 + wr * 64 + m * 16 + fr) * 2048 + c0;
#pragma unroll
                    for (int bj = 0; bj < 2; ++bj) { const f32x4 v0 = acc[ai][bj][m][0], v1 = acc[ai][bj][m][1];
                        u32x4 w; w.x = pk2(v0.x, v0.y); w.y = pk2(v0.z, v0.w); w.z = pk2(v1.x, v1.y); w.w = pk2(v1.z, v1.w); *(u32x4*)(op + 128 * bj) = w; } }
        }
    }
};
template <int ACT> struct EpiPairBf16 {
    static constexpr int PERM = 1;
    KP k; int l;
    __device__ __forceinline__ void operator()(const f32x4 (&acc)[2][2][4][2], const Unit& u, int wr, int wc, int fr, int fq) const {
        const KP kk = fresh(k);
        unsigned char* Ob = as_global(kk->ws) + (ACT == 0 ? OFF_Z : OFF_HM);
        const float* bb = ACT == 0 ? as_global(kk->in[I_PW1B]) : (const float*)(as_global(kk->ws) + OFF_BGUP) + (size_t)(l * NE + u.e) * 2048;
        const int j0 = u.pn * 128 + wc * 32 + 8 * fq;
        f32x4 ba[2], bg[2];
#pragma unroll
        for (int n = 0; n < 2; ++n) {
            if (ACT == 0) { ba[n] = *(const f32x4*)(bb + j0 + 4 * n); bg[n] = *(const f32x4*)(bb + 1024 + j0 + 4 * n); }
            else { const int q = u.pn * 256 + wc * 32 + 8 * fq + 4 * n; ba[n] = *(const f32x4*)(bb + q); bg[n] = *(const f32x4*)(bb + 128 + q); } }
#pragma unroll
        for (int ai = 0; ai < 2; ++ai)
#pragma unroll
            for (int m = 0; m < 4; ++m) { const size_t orow = (size_t)(u.row0 + ai * 128 + wr * 64 + m * 16 + fr);
                float r[8];
#pragma unroll
                for (int n = 0; n < 2; ++n) { const float dq = 1.f / W8_SCALE; const f32x4 a = acc[ai][0][m][n] * dq + ba[n], g = acc[ai][1][m][n] * dq + bg[n];
#pragma unroll
                    for (int q = 0; q < 4; ++q) {
                        if (ACT == 0) r[4 * n + q] = a[q] * sigm(g[q]);
                        else { const float gt = fminf(a[q], 7.0f), up = fminf(fmaxf(g[q], -7.0f), 7.0f);
                            const float rc = __builtin_amdgcn_rcpf(1.f + __builtin_amdgcn_exp2f(gt * (-1.702f * 1.44269504088896f))); r[4 * n + q] = (gt * rc) * __builtin_fmaf(up, H8_SCALE, H8_SCALE); } } }
                if (ACT == 0) { u32x4 w; w.x = pk2(r[0], r[1]); w.y = pk2(r[2], r[3]); w.z = pk2(r[4], r[5]); w.w = pk2(r[6], r[7]); *(u32x4*)(Ob + orow * 2048 + j0 * 2) = w; }
                else { u32x2 w; w.x = pk4_fp8(r[0], r[1], r[2], r[3]); w.y = pk4_fp8(r[4], r[5], r[6], r[7]); *(u32x2*)(Ob + orow * 1024 + j0) = w; } }
    }
};
struct EpiMoe2 {
    static constexpr int PERM = 2;
    KP k; int l; const LAS int* tflat; const LAS float* tgate;
    __device__ __forceinline__ void operator()(const f32x4 (&acc)[2][2][4][2], const Unit& u, int wr, int wc, int fr, int fq) const {
        const KP kk = fresh(k); unsigned char* Y = as_global(kk->ws) + OFF_Y;
        const int c0 = u.pn * 256 + wc * 64 + 16 * fq; const float* bb = as_global(kk->in[I_BD]) + (size_t)(l * NE + u.e) * D;
        f32x4 bv[2][2];
#pragma unroll
        for (int bj = 0; bj < 2; ++bj)
#pragma unroll
            for (int n = 0; n < 2; ++n) bv[bj][n] = *(const f32x4*)(bb + c0 + 8 * bj + 4 * n);
#pragma unroll
        for (int ai = 0; ai < 2; ++ai)
#pragma unroll
            for (int m = 0; m < 4; ++m) { const int r = ai * 128 + wr * 64 + m * 16 + fr;
                if (r < u.nvalid) { const int flat = tflat[u.ui * 256 + r]; const float gt = tgate[u.ui * 256 + r] * Y8_SCALE; const float dq = 1.f / (W8_SCALE * H8_SCALE);
                    const f32x4 v00 = (acc[ai][0][m][0] * dq + bv[0][0]) * gt, v01 = (acc[ai][0][m][1] * dq + bv[0][1]) * gt, v10 = (acc[ai][1][m][0] * dq + bv[1][0]) * gt, v11 = (acc[ai][1][m][1] * dq + bv[1][1]) * gt;
                    u32x4 w; w.x = pk4_fp8_sat(v00.x, v00.y, v00.z, v00.w); w.y = pk4_fp8_sat(v01.x, v01.y, v01.z, v01.w); w.z = pk4_fp8_sat(v10.x, v10.y, v10.z, v10.w); w.w = pk4_fp8_sat(v11.x, v11.y, v11.z, v11.w);
                    *(u32x4*)(Y + (size_t)flat * D + c0) = w; } }
    }
};

template <bool FP8> __device__ __forceinline__ f32x4 mma_one(const bf16x8& b0, const bf16x8& b1, const bf16x8& a0, const bf16x8& a1, const f32x4& c, int kk) {
    if constexpr (FP8) { const i32x4 bl = __builtin_bit_cast(i32x4, b0), bh = __builtin_bit_cast(i32x4, b1), al = __builtin_bit_cast(i32x4, a0), ah = __builtin_bit_cast(i32x4, a1);
        const i32x8 bv = __builtin_shufflevector(bl, bh, 0, 1, 2, 3, 4, 5, 6, 7), av = __builtin_shufflevector(al, ah, 0, 1, 2, 3, 4, 5, 6, 7);
        return __builtin_amdgcn_mfma_scale_f32_16x16x128_f8f6f4(bv, av, c, 0, 0, 0, 0, 0, 0); }
    else return __builtin_amdgcn_mfma_f32_16x16x32_bf16(kk ? b1 : b0, kk ? a1 : a0, c, 0, 0, 0);
}
template <class Epi, class Sched, bool FP8 = false>
__device__ __forceinline__ void gemm_phase(LAS unsigned char* lds, KP k, size_t a_off, const Sched& S, const Epi& E, int wv) {
    const char* Abase = (const char*)(as_global(fresh(k)->ws) + a_off);
    const int tid = opaque_tid(wv), wid = __builtin_amdgcn_readfirstlane(tid >> 6), lane = tid & 63, wr = wid >> 2, wc = wid & 3, fr = lane & 15, fq = lane >> 4;
    constexpr int ROWB = Sched::ROWB, nt = ROWB / 128, KOFF = 1024;
    static_assert(FP8 == (ROWB == 1024), "operand row pitch");
    int sR[2], sC[2]; unsigned voffB[2];
#pragma unroll
    for (int i = 0; i < 2; ++i) { stage_rc(tid * 16 + i * 8192, sR[i], sC[i]); const int Rb = Epi::PERM == 1 ? ((sR[i] & ~31) + perm32(sR[i] & 31)) : Epi::PERM == 2 ? 64 * (sR[i] >> 5) + 16 * ((sR[i] & 15) >> 2) + 4 * ((sR[i] >> 4) & 1) + (sR[i] & 3) : sR[i]; voffB[i] = (unsigned)(Rb * ROWB + sC[i] * 2); }
    constexpr size_t kstep = 128, hstep = (size_t)(Epi::PERM == 2 ? 8 : HALF) * ROWB;
    const unsigned ldsw = (unsigned)wid * 1024u;
    const int fcol = fq * 8;
    const int aoff = lds_byte(wr * 64 + fr, fcol), boff = lds_byte(wc * 32 + fr, fcol);
#define PG8_SA(b, h) (((b) * 2 + (h)) * HTB)
#define PG8_SB(b, h) ((4 + (b) * 2 + (h)) * HTB)
#define PG8_STAGE(bufoff, gbase, voff) do { _Pragma("unroll") for (int _i = 0; _i < 2; ++_i) \
        __builtin_amdgcn_global_load_lds((const unsigned*)((const char*)(gbase) + (voff)[_i]), (LAS unsigned*)(lds + (bufoff) + ldsw + _i * 8192), 16, 0, 0); } while (0)
#define PG8_LDA(dst, b, h) do { _Pragma("unroll") for (int m = 0; m < 4; ++m) _Pragma("unroll") for (int k = 0; k < 2; ++k) dst[m][k] = *(const LAS bf16x8*)(lds + PG8_SA(b, h) + aoff + m * 2048 + k * KOFF); } while (0)
#define PG8_LDB(dst, b, h) do { _Pragma("unroll") for (int n = 0; n < 2; ++n) _Pragma("unroll") for (int k = 0; k < 2; ++k) dst[n][k] = *(const LAS bf16x8*)(lds + PG8_SB(b, h) + boff + n * 2048 + k * KOFF); } while (0)
#define PG8_MMA(ai, bj, At, Bt) do { __builtin_amdgcn_s_setprio(1); _Pragma("unroll") for (int m = 0; m < 4; ++m) _Pragma("unroll") for (int n = 0; n < 2; ++n) _Pragma("unroll") for (int k = 0; k < (FP8 ? 1 : 2); ++k) \
        acc[ai][bj][m][n] = mma_one<FP8>(Bt[n][0], Bt[n][1], At[m][0], At[m][1], acc[ai][bj][m][n], k); __builtin_amdgcn_s_setprio(0); } while (0)
#define PG8_WAIT_V(n) asm volatile("s_waitcnt vmcnt(" #n ")" ::: "memory")
#define PG8_WAIT_L(n) asm volatile("s_waitcnt lgkmcnt(" #n ")" ::: "memory")
#define PG8_BAR __builtin_amdgcn_s_barrier()
#define PG8_SCHED __builtin_amdgcn_sched_barrier(0)
    Unit cur, nxt; int ui = 0;
    if (!S.next(0, cur)) return;
    f32x4 acc[2][2][4][2];
#pragma unroll
    for (int a = 0; a < 2; ++a)
#pragma unroll
        for (int b = 0; b < 2; ++b)
#pragma unroll
            for (int m = 0; m < 4; ++m)
#pragma unroll
                for (int n = 0; n < 2; ++n) acc[a][b][m][n] = (f32x4){0.f, 0.f, 0.f, 0.f};
    bf16x8 At[4][2], B0[2][2], B1[2][2];
    unsigned voffA[2][2];
#pragma unroll
    for (int h = 0; h < 2; ++h)
#pragma unroll
        for (int i = 0; i < 2; ++i) voffA[h][i] = S.aoff(cur, 0, h * 128 + sR[i], sC[i]);
    const char* cB = cur.B;
#define PG8_KT(j, rot) ((size_t)(((j) + (rot)) & (nt - 1)) * kstep)
    int crot = cur.rot;
    { const size_t k0 = PG8_KT(0, crot), k1 = PG8_KT(1, crot);
    PG8_STAGE(PG8_SB(0, 0), cB + k0, voffB); PG8_STAGE(PG8_SB(0, 1), cB + hstep + k0, voffB); PG8_STAGE(PG8_SA(0, 0), Abase + k0, voffA[0]); PG8_STAGE(PG8_SA(0, 1), Abase + k0, voffA[1]);
    if (wr == 1) PG8_BAR;
    PG8_WAIT_V(2); PG8_BAR;
    PG8_STAGE(PG8_SB(1, 0), cB + k1, voffB); PG8_STAGE(PG8_SA(1, 0), Abase + k1, voffA[0]); PG8_STAGE(PG8_SB(1, 1), cB + hstep + k1, voffB); }
    PG8_WAIT_V(6); PG8_BAR;
    for (;;) {
        const bool has_next = S.next(ui + 1, nxt);
        const char* nB = has_next ? nxt.B : cB; const int nrot = has_next ? nxt.rot : 0;
        for (int t = 0; t < nt; t += 2) {
            const bool last = (t == nt - 2);
            const size_t o1 = PG8_KT(t + 1, crot), o2 = last ? PG8_KT(0, nrot) : PG8_KT(t + 2, crot), o3 = last ? PG8_KT(1, nrot) : PG8_KT(t + 3, crot);
            const char* a1 = Abase + o1;
            const char* a2 = Abase + o2; const char* b2 = (last ? nB : cB) + o2;
            const char* a3 = Abase + o3; const char* b3 = (last ? nB : cB) + o3;
            PG8_LDB(B0, 0, 0); PG8_LDB(B1, 0, 1); PG8_SCHED; PG8_LDA(At, 0, 0); PG8_STAGE(PG8_SA(1, 1), a1, voffA[1]);
            if (last && has_next) {
#pragma unroll
                for (int h = 0; h < 2; ++h)
#pragma unroll
                    for (int i = 0; i < 2; ++i) voffA[h][i] = S.aoff(nxt, ui + 1, h * 128 + sR[i], sC[i]);
            }
            PG8_WAIT_V(8); PG8_WAIT_L(0); PG8_BAR; PG8_MMA(0, 0, At, B0); PG8_MMA(0, 1, At, B1); PG8_BAR; PG8_SCHED;
            PG8_LDA(At, 0, 1); PG8_STAGE(PG8_SB(0, 0), b2, voffB); PG8_STAGE(PG8_SB(0, 1), b2 + hstep, voffB); PG8_STAGE(PG8_SA(0, 0), a2, voffA[0]);
            PG8_WAIT_V(8); PG8_WAIT_L(0); PG8_BAR; PG8_MMA(1, 0, At, B0); PG8_MMA(1, 1, At, B1); PG8_BAR; PG8_SCHED;
            PG8_LDB(B0, 1, 0); PG8_LDB(B1, 1, 1); PG8_SCHED; PG8_LDA(At, 1, 0); PG8_STAGE(PG8_SA(0, 1), a2, voffA[1]);
            PG8_WAIT_V(8); PG8_WAIT_L(0); PG8_BAR; PG8_MMA(0, 0, At, B0); PG8_MMA(0, 1, At, B1); PG8_BAR; PG8_SCHED;
            PG8_LDA(At, 1, 1); PG8_STAGE(PG8_SB(1, 0), b3, voffB); PG8_STAGE(PG8_SB(1, 1), b3 + hstep, voffB); PG8_STAGE(PG8_SA(1, 0), a3, voffA[0]);
            PG8_WAIT_V(8); PG8_WAIT_L(0); PG8_BAR; PG8_MMA(1, 0, At, B0); PG8_MMA(1, 1, At, B1); PG8_BAR; PG8_SCHED;
        }
        if (wr == 0) PG8_BAR;
        E(acc, cur, wr, wc, fr, fq);
        if (!has_next) break;
#pragma unroll
        for (int a = 0; a < 2; ++a)
#pragma unroll
            for (int b = 0; b < 2; ++b)
#pragma unroll
                for (int m = 0; m < 4; ++m)
#pragma unroll
                    for (int n = 0; n < 2; ++n) acc[a][b][m][n] = (f32x4){0.f, 0.f, 0.f, 0.f};
        cur = nxt; cB = nB; crot = nrot; ++ui;
        if (wr == 1) PG8_BAR;
    }
    PG8_WAIT_V(0);
    PG8_BAR;
#undef PG8_KT
#undef PG8_SA
#undef PG8_SB
#undef PG8_STAGE
#undef PG8_LDA
#undef PG8_LDB
#undef PG8_MMA
#undef PG8_WAIT_V
#undef PG8_WAIT_L
#undef PG8_BAR
#undef PG8_SCHED
}
}

typedef float f32x16 __attribute__((ext_vector_type(16)));
__device__ __forceinline__ void s5_lam(const Cx& p, int jd, int g, int pp, float& lbr, float& lbi, float& qr, float& qi) {
    const f32x4 t = *(const f32x4*)(as_global(p.k->ws) + OFF_S5T + (size_t)((jd * 64 + g) * 64 + pp) * 16); lbr = t.x; lbi = t.y; qr = t.z; qi = t.w;
}
__device__ __forceinline__ int s5_tbi(int d, int B, int st) { return (d * 136 + B) * 64 + (st ^ ((B & 15) << 2)); }
__device__ __forceinline__ int s5_row(int b, int B, int t) { return B < 8 ? b * NCTX + 32 * B + t : RCTX + b * SEQ + 32 * (B - 8) + t; }
__device__ __forceinline__ void ph_s5(const Cx& p, int l, LAS unsigned char* lds) {
    const int tid = opaque_tid(p.wv), lane = tid & 63, wave = p.wv, n = lane & 31, h = lane >> 5, j = l / 3; const bool last = (l == DEPTH - 1);
    const bf16_t* HN = (const bf16_t*)(as_global(p.k->ws) + OFF_HN); bf16_t* A2 = (bf16_t*)(as_global(p.k->ws) + OFF_A2);
    LAS unsigned* Tb = (LAS unsigned*)lds;
    for (int wg = blockIdx.x; wg < NBATCH * 64; wg += gridDim.x) {
        const int tid = opaque_tid(p.wv), lane = tid & 63, n = lane & 31, h = lane >> 5;
        const int b = wg >> 6, g = wg & 63;
        const bf16_t* HNs = HN + (size_t)(b * 64 + g) * (NCTX + SEQ) * 16;
        float lbr[2], lbi[2];
#pragma unroll
        for (int d = 0; d < 2; ++d) { const int jd = j * 2 + d; float qr, qi; s5_lam(p, jd, g, lane, lbr[d], lbi[d], qr, qi); }
        WG_SYNC();
        {
            LAS unsigned char* Ub = lds + 69632;
            const int d = wave >> 2, mt = wave & 3;
            const unsigned char* WTg = as_global(p.k->ws) + OFF_WT + (size_t)((j * 64 + g) * 2 + d) * 131072;
            bf16x8 wf[32];
#pragma unroll
            for (int s = 0; s < 32; ++s) wf[s] = *(const bf16x8*)(WTg + ((mt * 32 + s) * 64 + lane) * 16);
            u32x4 uv[4];
#pragma unroll
            for (int q = 0; q < 4; ++q) { const int pc = tid + NTHR * q; uv[q] = *(const u32x4*)(HNs + (size_t)(pc >> 1) * 16 + 8 * (pc & 1)); }
#pragma unroll 1
            for (int nt = 0; nt < 5; ++nt) {
                WG_SYNC();
#pragma unroll
                for (int q = 0; q < 4; ++q) { const int pc = tid + NTHR * q, tk = pc >> 1, hf = pc & 1, nn = tk >> 5, s = tk & 31;
                    *(LAS u32x4*)(Ub + s * 1024 + ((nn ^ s) & 31) * 32 + hf * 16) = uv[q]; }
                WG_SYNC();
                if (nt < 4) {
#pragma unroll
                    for (int q = 0; q < 4; ++q) { const int pc = tid + NTHR * q, tok = 1024 * (nt + 1) + (pc >> 1);
                        uv[q] = (u32x4){0u, 0u, 0u, 0u}; if (tok < NCTX + SEQ) uv[q] = *(const u32x4*)(HNs + (size_t)tok * 16 + 8 * (pc & 1)); } }
                f32x16 e0, e1;
#pragma unroll
                for (int q = 0; q < 16; ++q) { e0[q] = 0.f; e1[q] = 0.f; }
#pragma unroll
                for (int s = 0; s < 32; s += 2) {
                    e0 = __builtin_amdgcn_mfma_f32_32x32x16_bf16(wf[s], *(const LAS bf16x8*)(Ub + s * 1024 + ((n ^ s) & 31) * 32 + h * 16), e0, 0, 0, 0);
                    e1 = __builtin_amdgcn_mfma_f32_32x32x16_bf16(wf[s + 1], *(const LAS bf16x8*)(Ub + (s + 1) * 1024 + ((n ^ (s + 1)) & 31) * 32 + h * 16), e1, 0, 0, 0); }
                const int B = 32 * nt + n;
                if (B < 136) {
#pragma unroll
                    for (int q = 0; q < 4; ++q) { u32x2 o; o.x = pk2(e0[4 * q] + e1[4 * q], e0[4 * q + 1] + e1[4 * q + 1]); o.y = pk2(e0[4 * q + 2] + e1[4 * q + 2], e0[4 * q + 3] + e1[4 * q + 3]);
                        *(LAS u32x2*)(Tb + (d * 136 + B) * 64 + 16 * mt + 4 * q + 2 * h) = o; } }
            }
        }
        WG_SYNC();
        if (wave < 2) { const int d = wave; float ar = lbr[d], ai = lbi[d];
#pragma unroll
            for (int q = 0; q < 5; ++q) { const float t2 = ar * ar - ai * ai; ai = 2.f * ar * ai; ar = t2; }
            float hr = 0.f, hi = 0.f;
#pragma unroll 1
            for (int i0 = 0; i0 < 136; i0 += 8) {
                unsigned e[8], o[8];
#pragma unroll
                for (int q = 0; q < 8; ++q) { const int i = i0 + q, B = d == 0 ? i : (i < 8 ? 7 - i : 143 - i); e[q] = Tb[(d * 136 + B) * 64 + lane]; }
#pragma unroll
                for (int q = 0; q < 8; ++q) { o[q] = pk2(hr, hi);
                    const float er = __uint_as_float(e[q] << 16), ei = __uint_as_float(e[q] & 0xffff0000u);
                    const float nr = ar * hr - ai * hi + er, ni = ar * hi + ai * hr + ei; hr = nr; hi = ni; }
#pragma unroll
                for (int q = 0; q < 8; ++q) { const int i = i0 + q, B = d == 0 ? i : (i < 8 ? 7 - i : 143 - i); Tb[(d * 136 + B) * 64 + lane] = o[q]; }
            }
        }
        WG_SYNC();
        {
            const int tid = opaque_tid(p.wv), lane = tid & 63, n = lane & 31, h = lane >> 5;
            for (int idx = tid; idx < 272 * 16; idx += NTHR) { const int row = idx >> 4, c = idx & 15, x = (row >= 136 ? row - 136 : row) & 15, c2 = c ^ x;
                if (c < c2) { LAS u32x4* pa = (LAS u32x4*)(Tb + row * 64 + c * 4); LAS u32x4* pb = (LAS u32x4*)(Tb + row * 64 + c2 * 4); const u32x4 va = *pa, vb = *pb; *pa = vb; *pb = va; } }
            LAS unsigned char* Ub = lds + 69632;
            LAS unsigned char* KTl = lds + 102400;
            { const unsigned char* KTg = as_global(p.k->ws) + OFF_KT + (size_t)(j * 64 + g) * 33792;
              for (int pc = tid; pc < 2112; pc += NTHR) *(LAS u32x4*)(KTl + pc * 16) = *(const u32x4*)(KTg + pc * 16); }
            const unsigned char* GTg = as_global(p.k->ws) + OFF_GT + (size_t)(j * 64 + g) * 262144;
            const int m0 = wave, m1 = 15 - wave, toff = n >> 4, hh = n & 15;
            bf16x8 gf[2][2][8];
#pragma unroll
            for (int d = 0; d < 2; ++d)
#pragma unroll
                for (int mi = 0; mi < 2; ++mi)
#pragma unroll
                    for (int ks = 0; ks < 8; ++ks) gf[d][mi][ks] = *(const bf16x8*)(GTg + d * 131072 + (((mi ? m1 : m0) * 8 + ks) * 64 + lane) * 16);
            const float* dd = as_global(p.k->in[I_S5D]) + j * D + 16 * g; const f32x4 dv0 = *(const f32x4*)(dd + 4 * h), dv1 = *(const f32x4*)(dd + 8 + 4 * h);
            const int offF = ((toff + 1) * 16 + hh) * 32 + h * 16, offR = ((34 - toff) * 16 + hh) * 32 + h * 16;
            unsigned char* A2b = (unsigned char*)A2;
            u32x4 uv[4];
#pragma unroll
            for (int q = 0; q < 4; ++q) { const int pc = tid + NTHR * q; uv[q] = *(const u32x4*)(HNs + (size_t)(pc >> 1) * 16 + 8 * (pc & 1)); }
#pragma unroll 1
            for (int nt = 0; nt < 5; ++nt) {
                WG_SYNC();
#pragma unroll
                for (int q = 0; q < 4; ++q) { const int pc = tid + NTHR * q, tk = pc >> 1, hf = pc & 1, nn = tk >> 5, s = tk & 31;
                    *(LAS u32x4*)(Ub + s * 1024 + ((nn ^ s) & 31) * 32 + hf * 16) = uv[q]; }
                WG_SYNC();
                f32x16 aF0, aF1;
#pragma unroll
                for (int q = 0; q < 16; ++q) { aF0[q] = 0.f; aF1[q] = 0.f; }
#pragma unroll 4
                for (int s = 0; s < 32; ++s) {
                    const bf16x8 bu = *(const LAS bf16x8*)(Ub + s * 1024 + ((n ^ s) & 31) * 32 + h * 16);
                    const int o0 = s <= 2 * m0 + 1 ? offF + (2 * m0 - s) * 512 : offR + (s - 2 * m0) * 512, o1 = s <= 2 * m1 + 1 ? offF + (2 * m1 - s) * 512 : offR + (s - 2 * m1) * 512;
                    aF0 = __builtin_amdgcn_mfma_f32_32x32x16_bf16(*(const LAS bf16x8*)(KTl + o0), bu, aF0, 0, 0, 0); aF1 = __builtin_amdgcn_mfma_f32_32x32x16_bf16(*(const LAS bf16x8*)(KTl + o1), bu, aF1, 0, 0, 0);
                }
#pragma unroll
                for (int e = 0; e < 2; ++e) { const int s0 = 2 * m0 + e, s1 = 2 * m1 + e;
                    const bf16x8 b0 = *(const LAS bf16x8*)(Ub + s0 * 1024 + ((n ^ s0) & 31) * 32 + h * 16), b1 = *(const LAS bf16x8*)(Ub + s1 * 1024 + ((n ^ s1) & 31) * 32 + h * 16);
                    const bf16x8 ar = *(const LAS bf16x8*)(KTl + offR + e * 512);
                    aF0 = __builtin_amdgcn_mfma_f32_32x32x16_bf16(ar, b0, aF0, 0, 0, 0); aF1 = __builtin_amdgcn_mfma_f32_32x32x16_bf16(ar, b1, aF1, 0, 0, 0); }
                const int Bc = min(32 * nt + n, 135);
#pragma unroll
                for (int ks = 0; ks < 8; ++ks) {
                    const bf16x8 h0 = *(const LAS bf16x8*)(Tb + s5_tbi(0, Bc, 8 * ks + 4 * h)), h1 = *(const LAS bf16x8*)(Tb + s5_tbi(1, Bc, 8 * ks + 4 * h));
                    aF0 = __builtin_amdgcn_mfma_f32_32x32x16_bf16(gf[0][0][ks], h0, aF0, 0, 0, 0); aF1 = __builtin_amdgcn_mfma_f32_32x32x16_bf16(gf[0][1][ks], h0, aF1, 0, 0, 0);
                    aF0 = __builtin_amdgcn_mfma_f32_32x32x16_bf16(gf[1][0][ks], h1, aF0, 0, 0, 0); aF1 = __builtin_amdgcn_mfma_f32_32x32x16_bf16(gf[1][1][ks], h1, aF1, 0, 0, 0);
                    if (ks & 1) __builtin_amdgcn_sched_barrier(0);
                }
                if (nt < 4) {
#pragma unroll
                    for (int q = 0; q < 4; ++q) { const int pc = tid + NTHR * q, tok = 1024 * (nt + 1) + (pc >> 1);
                        uv[q] = (u32x4){0u, 0u, 0u, 0u}; if (tok < NCTX + SEQ) uv[q] = *(const u32x4*)(HNs + (size_t)tok * 16 + 8 * (pc & 1)); } }
                {   LAS unsigned char* scr = lds + 140288 + wave * 2048;
#pragma unroll
                    for (int mi = 0; mi < 2; ++mi) { const int m = mi ? m1 : m0; const f32x16 y = mi ? aF1 : aF0;
#pragma unroll
                        for (int q4 = 0; q4 < 4; ++q4) { const int t = 2 * m + (q4 >> 1), c0 = 8 * (q4 & 1) + 4 * h;
                            const u32x2 uw = *(const LAS u32x2*)(Ub + t * 1024 + ((n ^ t) & 31) * 32 + c0 * 2); const f32x4 d4 = (q4 & 1) ? dv1 : dv0;
                            *(LAS unsigned*)(scr + ((mi * 2 + (q4 >> 1)) * 32 + n) * 16 + c0) = pk4_fp8_sat(gelu_tanh(y[4 * q4] + d4.x * bf2f(uw.x & 0xffffu)), gelu_tanh(y[4 * q4 + 1] + d4.y * bf2f(uw.x >> 16)),
                                                                                                              gelu_tanh(y[4 * q4 + 2] + d4.z * bf2f(uw.y & 0xffffu)), gelu_tanh(y[4 * q4 + 3] + d4.w * bf2f(uw.y >> 16))); } }
                    asm volatile("s_waitcnt lgkmcnt(0)" ::: "memory");
#pragma unroll
                    for (int k2 = 0; k2 < 2; ++k2) { const int sl = lane + 64 * k2, ti = sl >> 5, B = 32 * nt + (sl & 31), t = 2 * ((ti >> 1) ? m1 : m0) + (ti & 1);
                        const u32x4 o = *(const LAS u32x4*)(scr + sl * 16);
                        if (B < 136 && !(last && B < 8)) *(u32x4*)(A2b + (size_t)s5_row(b, B, t) * D + 16 * g) = o; }
                    asm volatile("s_waitcnt lgkmcnt(0)" ::: "memory");
                }
            }
        }
    }
}
__device__ __forceinline__ void ph_conv3(const Cx& p) {
    const bf16_t* Z = (const bf16_t*)(as_global(p.k->ws) + OFF_Z); bf16_t* A2 = (bf16_t*)(as_global(p.k->ws) + OFF_A2); const float* cw = as_global(p.k->in[I_SCCW]);
    const int tid = opaque_tid(p.wv);
    for (size_t i = (size_t)blockIdx.x * NTHR + tid; i < (size_t)RTOT * D / 4; i += (size_t)gridDim.x * NTHR) {
        const int row = (int)(i >> 8), col = (int)(i & 255) * 4;
        int pos, len; if (row < RCTX) { pos = row & 255; len = 256; } else { pos = (row - RCTX) & 63; len = 64; }
        f32x4 acc = (f32x4){0.f, 0.f, 0.f, 0.f};
#pragma unroll
        for (int d = 0; d < 3; ++d) { const int q = pos + d - 1; const bool ok = (q >= 0 && q < len);
            const bf16_t* zr = Z + (size_t)(ok ? row + d - 1 : row) * 2048; const f32x4 uu = ld_bf16x4(zr + col); f32x4 w = *(const f32x4*)(cw + d * D + col);
            if (!ok) w = (f32x4){0.f, 0.f, 0.f, 0.f};
            acc += w * uu; }
        const u32x2 gw = __builtin_nontemporal_load((const u32x2*)(Z + (size_t)row * 2048 + 1024 + col)); const f32x4 gb = (f32x4){bf2f(gw.x & 0xffffu), bf2f(gw.x >> 16), bf2f(gw.y & 0xffffu), bf2f(gw.y >> 16)}, o = gb * acc;
        *(unsigned*)((unsigned char*)A2 + (size_t)row * D + col) = pk4_fp8_sat(o.x, o.y, o.z, o.w);
    }
}
__device__ __forceinline__ void cf_ln_silu_store(const Cx& p, f32x4 (&a)[4], unsigned char* dst, int lane) {
    float s = 0.f;
#pragma unroll
    for (int j = 0; j < 4; ++j) s += (a[j].x + a[j].y) + (a[j].z + a[j].w);
    const float mu = wave_sum(s) * (1.f / D); float q2 = 0.f;
#pragma unroll
    for (int j = 0; j < 4; ++j) { a[j] = a[j] - mu; q2 += (a[j].x * a[j].x + a[j].y * a[j].y) + (a[j].z * a[j].z + a[j].w * a[j].w); }
    const float rstd = rsqrtf(wave_sum(q2) * (1.f / D) + 1e-5f);
    f32x4 o[4];
#pragma unroll
    for (int j = 0; j < 4; ++j) { const int col = 256 * j + 4 * lane; const f32x4 y = a[j] * rstd * *(const f32x4*)(as_global(p.k->in[I_LNG]) + col) + *(const f32x4*)(as_global(p.k->in[I_LNB]) + col);
        o[j] = (f32x4){silu(y.x), silu(y.y), silu(y.z), silu(y.w)}; }
    store_row_fp8(dst, lane, o);
}
__device__ __forceinline__ void ph_conv31(const Cx& p, LAS unsigned char* lds) {
    const int tid = opaque_tid(p.wv), lane = tid & 63, wave = p.wv;
    const bf16_t* U = (const bf16_t*)(as_global(p.k->ws) + OFF_Z); unsigned char* A2 = as_global(p.k->ws) + OFF_A2; bf16_t* T2 = (bf16_t*)(as_global(p.k->ws) + OFF_HN);
    const float* dw = as_global(p.k->in[I_DWW]);
    for (int item = blockIdx.x; item < NBATCH * 64; item += gridDim.x) {
        const int base = RCTX + (item >> 6) * SEQ + (item & 63);
        WG_SYNC();
#pragma unroll 4
        for (int q = 0; q < 16; ++q) { const int ch = tid + NTHR * q, r = ch >> 7, o16 = ch & 127;
            *(LAS u32x4*)(lds + r * 2048 + o16 * 16) = __builtin_nontemporal_load((const u32x4*)(U + (size_t)(base + 64 * r) * D + o16 * 8)); }
        WG_SYNC();
#pragma unroll 1
        for (int pass = 0; pass < 2; ++pass) {
            const int c0 = 128 * wave + 64 * pass + lane; const LAS unsigned char* col = lds + c0 * 2;
            float w0[31];
#pragma unroll
            for (int d = 0; d < 31; ++d) w0[d] = dw[d * D + c0];
            const float bb = as_global(p.k->in[I_DWB])[c0];
#pragma unroll 1
            for (int blk = 0; blk < 8; ++blk) {
                float in[38];
#pragma unroll
                for (int j = 0; j < 38; ++j) { const int rr = 8 * blk - 15 + j; const int rc = rr < 0 ? 0 : (rr > 63 ? 63 : rr);
                    const float v = __uint_as_float((unsigned)*(const LAS unsigned short*)(col + rc * 2048) << 16); in[j] = (rr >= 0 && rr < 64) ? v : 0.f; }
#pragma unroll
                for (int q = 0; q < 8; ++q) { float a0 = bb;
#pragma unroll
                    for (int d = 0; d < 31; ++d) a0 = fmaf(w0[d], in[q + d], a0);
                    *(unsigned short*)(T2 + (size_t)(base + 64 * (8 * blk + q)) * D + c0) = (unsigned short)(pk2(a0, 0.f) & 0xffffu); }
            }
        }
        asm volatile("s_waitcnt vmcnt(0)" ::: "memory");
        WG_SYNC();
        for (int r = wave; r < 64; r += NWV) { f32x4 a[4]; const bf16_t* pr = T2 + (size_t)(base + 64 * r) * D;
#pragma unroll
            for (int j = 0; j < 4; ++j) a[j] = ld_bf16x4(pr + 256 * j + 4 * lane);
            cf_ln_silu_store(p, a, A2 + (size_t)(base + 64 * r) * D, lane); }
    }
    for (int row = blockIdx.x * NWV + wave; row < RCTX; row += gridDim.x * NWV) {
        const int pos = row & 255, base = row - pos;
        f32x4 a[4];
#pragma unroll
        for (int j = 0; j < 4; ++j) a[j] = *(const f32x4*)(as_global(p.k->in[I_DWB]) + 256 * j + 4 * lane);
        for (int d = 0; d < 31; ++d) { const int q = pos + d - 15;
            if (q >= 0 && q < 256) { const bf16_t* ur = U + (size_t)(base + q) * D;
#pragma unroll
                for (int j = 0; j < 4; ++j) { const int col = 256 * j + 4 * lane; a[j] += *(const f32x4*)(dw + d * D + col) * ld_bf16x4(ur + col); } } }
        cf_ln_silu_store(p, a, A2 + (size_t)row * D, lane);
    }
}
__device__ __forceinline__ void ph_route(const Cx& p, int l, LAS unsigned char* lds) {
    const int tid = opaque_tid(p.wv), lane = tid & 63, wave = p.wv, n = lane & 31, h = lane >> 5;
    const bf16_t* X = (const bf16_t*)(as_global(p.k->ws) + OFF_X); bf16_t* F = (bf16_t*)(as_global(p.k->ws) + OFF_F); const float* mod = (const float*)(as_global(p.k->ws) + OFF_MOD);
    float* gate = (float*)(as_global(p.k->ws) + OFF_GATE); int* elist = (int*)(as_global(p.k->ws) + OFF_ELIST); unsigned* cnt = (unsigned*)(as_global(p.k->ws) + OFF_CTL) + CW_CNT + l * 32;
    const float* rb = as_global(p.k->in[I_RB]) + l * NE;
    constexpr int TS = 2064;
    LAS unsigned char* tile = lds;
    LAS float* part = (LAS float*)(lds + 32 * TS);
    LAS int* lcnt = (LAS int*)(lds + 32 * TS + 32768);
    LAS int* choice = lcnt + 64;
    const int row_lo = (l == DEPTH - 1) ? RCTX : 0, nrows = RTOT - row_lo, G = gridDim.x;
    const int per = (nrows + G - 1) / G, r0 = row_lo + blockIdx.x * per, r1 = min(r0 + per, RTOT);
    bf16x8 Bw[8];
    { const bf16_t* rt = (const bf16_t*)(as_global(p.k->ws) + OFF_RWT) + ((size_t)l * NE + n) * D + 128 * wave + 8 * h;
#pragma unroll
      for (int s = 0; s < 8; ++s) Bw[s] = *(const bf16x8*)(rt + 16 * s); }
    if (tid < 32) lcnt[tid] = 0;
    WG_SYNC();
    for (int rb0 = r0; rb0 < r1; rb0 += 32) {
        const int nb = min(32, r1 - rb0);
        for (int q = wave; q < 32; q += NWV) {
            if (q < nb) { const int row = rb0 + q; f32x4 v[4], f[4]; load_row_bf16(X + (size_t)row * D, lane, v);
                const float rs = rsqrtf(row_sumsq(v) * (1.f / D) + 1e-6f);
                const float* m = mod + (size_t)(l * 5 + row_bi(row)) * 6144;
                norm_mod(v, rs, as_global(p.k->in[I_N2G]) + l * D, m + 4096, m + 3072, lane, f);
#pragma unroll
                for (int j = 0; j < 4; ++j) { u32x2 w; w.x = pk2(f[j].x, f[j].y); w.y = pk2(f[j].z, f[j].w);
                    *(unsigned*)((unsigned char*)F + (size_t)row * D + 256 * j + 4 * lane) = pk4_fp8_sat(f[j].x, f[j].y, f[j].z, f[j].w); *(LAS u32x2*)(tile + q * TS + (256 * j + 4 * lane) * 2) = w; }
            } else {
#pragma unroll
                for (int j = 0; j < 4; ++j) *(LAS u32x2*)(tile + q * TS + (256 * j + 4 * lane) * 2) = (u32x2){0u, 0u};
            }
        }
        WG_SYNC();
        { f32x16 acc;
#pragma unroll
          for (int i = 0; i < 16; ++i) acc[i] = 0.f;
#pragma unroll
          for (int s = 0; s < 8; ++s) { const bf16x8 af = *(const LAS bf16x8*)(tile + n * TS + (128 * wave + 16 * s + 8 * h) * 2); acc = __builtin_amdgcn_mfma_f32_32x32x16_bf16(af, Bw[s], acc, 0, 0, 0); }
#pragma unroll
          for (int r = 0; r < 16; ++r) { const int t = (r & 3) + 8 * (r >> 2) + 4 * h; part[(wave * 32 + t) * 32 + n] = acc[r]; } }
        WG_SYNC();
        if (tid < nb) { const int row = rb0 + tid;
            float lg[32];
#pragma unroll
            for (int e4 = 0; e4 < 8; ++e4) { f32x4 s = *(const f32x4*)(rb + 4 * e4);
#pragma unroll
                for (int w = 0; w < 8; ++w) s += *(const LAS f32x4*)(part + (w * 32 + tid) * 32 + 4 * e4);
                lg[4 * e4] = s.x; lg[4 * e4 + 1] = s.y; lg[4 * e4 + 2] = s.z; lg[4 * e4 + 3] = s.w; }
            float bv[4]; int bx[4]; unsigned taken = 0u;
#pragma unroll
            for (int k = 0; k < 4; ++k) { float best = -3.0e38f; int idx = 0;
#pragma unroll
                for (int e = 0; e < 32; ++e) { const bool c = !((taken >> e) & 1u) && lg[e] > best; best = c ? lg[e] : best; idx = c ? e : idx; }
                taken |= 1u << idx; bv[k] = best; bx[k] = idx; }
            const float e1 = __expf(bv[1] - bv[0]), e2 = __expf(bv[2] - bv[0]), e3 = __expf(bv[3] - bv[0]), inv = 1.f / (1.f + e1 + e2 + e3);
            *(f32x4*)(gate + (size_t)row * 4) = (f32x4){inv, e1 * inv, e2 * inv, e3 * inv};
#pragma unroll
            for (int k = 0; k < 4; ++k) { const int rank = __hip_atomic_fetch_add(lcnt + bx[k], 1, __ATOMIC_RELAXED, __HIP_MEMORY_SCOPE_WORKGROUP); choice[(row - r0) * 4 + k] = bx[k] | (rank << 8); }
        }
        WG_SYNC();
    }
    if (tid < 32) { const int c = lcnt[tid]; lcnt[32 + tid] = c ? (int)atomicAdd(&cnt[tid], (unsigned)c) : 0; }
    WG_SYNC();
    for (int i = tid; i < (r1 - r0) * 4; i += NTHR) { const int c = choice[i], e = c & 0xff, rank = c >> 8; elist[e * CAP + lcnt[32 + e] + rank] = (r0 + (i >> 2)) * 4 + (i & 3); }
}
__device__ __forceinline__ void ph_combine(const Cx& p, int l) {
    const int tid = opaque_tid(p.wv), lane = tid & 63, wave = tid >> 6; const bool last = (l == DEPTH - 1);
    bf16_t* X = (bf16_t*)(as_global(p.k->ws) + OFF_X); bf16_t* HN = (bf16_t*)(as_global(p.k->ws) + OFF_HN); const bf16_t* Y = (const bf16_t*)(as_global(p.k->ws) + OFF_Y); const float* mod = (const float*)(as_global(p.k->ws) + OFF_MOD);
    const int row_lo = last ? RCTX : 0;
    for (int row = row_lo + blockIdx.x * NWV + wave; row < RTOT; row += gridDim.x * NWV) {
        f32x4 v[4], o[4]; load_row_bf16(X + (size_t)row * D, lane, v);
        const float* m = mod + (size_t)(l * 5 + row_bi(row)) * 6144;
#pragma unroll
        for (int j = 0; j < 4; ++j) { const int col = 256 * j + 4 * lane; const unsigned char* y = (const unsigned char*)Y + (size_t)row * 4 * D + col;
            f32x4 s = (f32x4){0.f, 0.f, 0.f, 0.f};
#pragma unroll
            for (int q = 0; q < 4; ++q) { const int w = __builtin_nontemporal_load((const int*)(y + q * D)); const f32x2 lo = __builtin_amdgcn_cvt_pk_f32_fp8(w, false), hi = __builtin_amdgcn_cvt_pk_f32_fp8(w, true); s += (f32x4){lo.x, lo.y, hi.x, hi.y}; }
            v[j] += *(const f32x4*)(m + 5120 + col) * (s * (1.f / Y8_SCALE)); }
        const float rs = rsqrtf(row_sumsq(v) * (1.f / D) + 1e-6f);
        if (last) {
            float* op = as_global(p.k->out) + (size_t)(row - RCTX) * D;
#pragma unroll
            for (int j = 0; j < 4; ++j) { const int col = 256 * j + 4 * lane; *(f32x4*)(op + col) = v[j] * rs * *(const f32x4*)(as_global(p.k->in[I_FING]) + col); }
        } else {
            store_row_bf16(X + (size_t)row * D, lane, v);
            const float* m2 = mod + (size_t)((l + 1) * 5 + row_bi(row)) * 6144;
            norm_mod(v, rs, as_global(p.k->in[I_N1G]) + (l + 1) * D, m2 + 1024, m2, lane, o);
            if ((l + 1) % 3 == 0) store_row_s5(HN, row, lane, o); else if ((l + 1) % 3 == 2) store_row_fp8((unsigned char*)HN + (size_t)row * D, lane, o);
            else store_row_bf16(HN + (size_t)row * D, lane, o);
        }
    }
}

__device__ __forceinline__ int moe_setup(const Cx& p, int l, LAS unsigned char* lds, int NTl, bool gather) {
    LAS int* pt = (LAS int*)(lds + LDS_MISC); LAS int* desc = (LAS int*)(lds + LDS_MISC + 512); LAS int* tab = (LAS int*)(lds + LDS_MISC + 1024);
    const int tid = opaque_tid(p.wv), G = gridDim.x, c = blockIdx.x;
    const int* cnt = (const int*)(as_global(p.k->ws) + OFF_CTL) + CW_CNT + l * 32; const int* elist = (const int*)(as_global(p.k->ws) + OFF_ELIST);
    WG_SYNC();
    if (tid == 0) { int s = 0; for (int e = 0; e < 32; ++e) { pt[e] = s; s += (cnt[e] + 255) >> 8; } pt[32] = s; }
    WG_SYNC();
    const int TMt = pt[32], S8 = G >> 3, x8 = c & 7, s8 = c >> 3, lo8 = (x8 * TMt) >> 3, ux = ((((x8 + 1) * TMt) >> 3) - lo8) * NTl;
    int nu = ux > s8 ? (ux - s8 + S8 - 1) / S8 : 0; if (nu > g8::MOE_MAX_UNITS) nu = g8::MOE_MAX_UNITS;
    if (tid < nu) { const int q = tid * S8 + s8, al = q / NTl, mg = lo8 + al; int pn = q % NTl; pn |= ((NTl == 8 ? pn + 2 * al : 2 * pn + al) & 7) << 8; int e = 0;
        for (int q = 1; q < 32; ++q) if (pt[q] <= mg) e = q;
        const int mt = mg - pt[e]; const int nv = min(256, cnt[e] - mt * 256);
        desc[4 * tid] = e; desc[4 * tid + 1] = mg; desc[4 * tid + 2] = nv | (mt << 16); desc[4 * tid + 3] = pn; }
    WG_SYNC();
    if (gather) {
        const int nt_ = nu < g8::MOE_TAB_UNITS ? nu : g8::MOE_TAB_UNITS;
        for (int i = tid; i < nt_ * 256; i += NTHR) { const int ui = i >> 8, r = i & 255; const int e = desc[4 * ui], nvm = desc[4 * ui + 2], nv = nvm & 0xffff, mt = nvm >> 16;
            tab[i] = r < nv ? (elist[e * CAP + mt * 256 + r] >> 2) * 1024 : 0; }
        if (nu > g8::MOE_TAB_UNITS) nu = g8::MOE_TAB_UNITS;
        WG_SYNC();
    } else {
        if (nu > 6) nu = 6;
        const float* gate = (const float*)(as_global(p.k->ws) + OFF_GATE); LAS float* tg = (LAS float*)(tab + 2048);
        for (int i = tid; i < nu * 256; i += NTHR) { const int ui = i >> 8, r = i & 255; const int e = desc[4 * ui], nvm = desc[4 * ui + 2], nv = nvm & 0xffff, mt = nvm >> 16;
            const int flat = r < nv ? elist[e * CAP + mt * 256 + r] : 0; tab[i] = flat; tg[i] = r < nv ? gate[flat] : 0.f; }
        WG_SYNC();
    }
    return __builtin_amdgcn_readfirstlane(nu);
}
enum { PH_PREP = 0, PH_MOD, PH_NORM0, PH_S5, PH_S5POST, PH_GLU, PH_SCIN, PH_CONV3, PH_SCOUT, PH_PW1, PH_CONV31, PH_PW2, PH_ROUTE, PH_MOE1, PH_MOE2, PH_COMBINE };

template <int PH> __device__ __forceinline__ void run_phase(const Cx& p_in, int l, LAS unsigned char* lds) {
    Cx p = p_in; asm volatile("" : "+s"(p.k));
    const int G = gridDim.x, c = blockIdx.x;
    if constexpr (PH == PH_PREP) ph_prep(p, lds);
    if constexpr (PH == PH_MOD) ph_mod(p, lds);
    if constexpr (PH == PH_NORM0) ph_norm_first(p);
    if constexpr (PH == PH_S5) ph_s5(p, l, lds);
    if constexpr (PH == PH_CONV3) ph_conv3(p);
    if constexpr (PH == PH_CONV31) ph_conv31(p, lds);
    if constexpr (PH == PH_ROUTE) { if (l > 0) { const int pk = (l - 1) % 3; const int covered = pk == 0 ? tail_cap(68 * 8, G) : pk == 1 ? tail_cap(68 * 12, G) + tail_cap(68 * 4, G) : tail_cap(68 * 8, G) + tail_cap(68 * 4, G);
            conv_catchup(p, lds, l, covered); }
        ph_route(p, l, lds); }
    if constexpr (PH == PH_COMBINE) ph_combine(p, l);
    if constexpr (PH == PH_GLU) { const bool last = (l == DEPTH - 1);
        g8::SchedDense8 S{p.k, OFF_WGLU + (size_t)(l / 3) * 2 * MiB, last ? RCTX : 0, last ? 64 : 68, 8, G, c}; g8::EpiGluRes E{p.k, l};
        g8::gemm_phase<g8::EpiGluRes, g8::SchedDense8, true>(lds, p.k, OFF_A2, S, E, p.wv);
        if (!last) tail_convert(p, lds, l + 1, 0, 68 * 8); }
    if constexpr (PH == PH_SCIN) { g8::SchedDense S{p.k, OFF_WSCIN, 0, 68, 12, G, c}; g8::EpiScin E{p.k}; g8::gemm_phase(lds, p.k, OFF_HN, S, E, p.wv); tail_convert(p, lds, l + 1, 0, 68 * 12); }
    if constexpr (PH == PH_SCOUT) { g8::SchedDense8 S{p.k, OFF_WSCOUT, 0, 68, 4, G, c}; g8::EpiRes E{p.k, l, -1}; g8::gemm_phase<g8::EpiRes, g8::SchedDense8, true>(lds, p.k, OFF_A2, S, E, p.wv); tail_convert(p, lds, l + 1, tail_cap(68 * 12, G), 68 * 4); }
    if constexpr (PH == PH_PW1) { g8::SchedDense8 S{p.k, OFF_WPW1, 0, 68, 8, G, c}; g8::EpiPairBf16<0> E{p.k, l}; g8::gemm_phase<g8::EpiPairBf16<0>, g8::SchedDense8, true>(lds, p.k, OFF_HN, S, E, p.wv); tail_convert(p, lds, l + 1, 0, 68 * 8); }
    if constexpr (PH == PH_PW2) { g8::SchedDense8 S{p.k, OFF_WPW2, 0, 68, 4, G, c}; g8::EpiRes E{p.k, l, I_PW2B}; g8::gemm_phase<g8::EpiRes, g8::SchedDense8, true>(lds, p.k, OFF_A2, S, E, p.wv); tail_convert(p, lds, l + 1, tail_cap(68 * 8, G), 68 * 4); }
    if constexpr (PH == PH_MOE1) { const int nu = moe_setup(p, l, lds, 8, true);
        g8::SchedMoe S{p.k, OFF_WGU + (size_t)l * 64 * MiB, (size_t)2 * MiB, (const LAS int*)(lds + LDS_MISC + 512), (const LAS int*)(lds + LDS_MISC + 1024), nu, true};
        g8::EpiPairBf16<1> E{p.k, l}; g8::gemm_phase<g8::EpiPairBf16<1>, g8::SchedMoe, true>(lds, p.k, OFF_F, S, E, p.wv); }
    if constexpr (PH == PH_MOE2) { const int nu = moe_setup(p, l, lds, 4, false);
        g8::SchedMoe S{p.k, OFF_WD + (size_t)l * 32 * MiB, (size_t)1 * MiB, (const LAS int*)(lds + LDS_MISC + 512), (const LAS int*)(lds + LDS_MISC + 1024), nu, false};
        g8::EpiMoe2 E{p.k, l, (const LAS int*)(lds + LDS_MISC + 1024), (const LAS float*)(lds + LDS_MISC + 1024 + 8192)}; g8::gemm_phase<g8::EpiMoe2, g8::SchedMoe, true>(lds, p.k, OFF_HM, S, E, p.wv); }
}

#define NO_PK_F32 __attribute__((target("no-packed-fp32-ops")))
template <int PH> __global__ void NO_PK_F32 __launch_bounds__(NTHR, 2) k_ph(P p0, int l) {
    extern __shared__ __attribute__((aligned(16))) unsigned char shm[];
    Cx p; p.k = (KP)__builtin_amdgcn_kernarg_segment_ptr(); p.wv = __builtin_amdgcn_readfirstlane(threadIdx.x >> 6);
    run_phase<PH>(p, l, (LAS unsigned char*)shm);
}
#ifndef MK_MULTI
__global__ void NO_PK_F32 __launch_bounds__(NTHR, 2) fwd(P p0) {
    extern __shared__ __attribute__((aligned(16))) unsigned char shm[];
    LAS unsigned char* lds = (LAS unsigned char*)shm;
    Cx p; p.k = (KP)__builtin_amdgcn_kernarg_segment_ptr(); p.wv = __builtin_amdgcn_readfirstlane(threadIdx.x >> 6);
    volatile LAS unsigned* bst = (volatile LAS unsigned*)(lds + LDS_MISC + 256);
    if (threadIdx.x == 0) { bst[0] = 0u; bst[1] = 0u; bst[2] = 0u; bst[3] = 0u; }
    WG_SYNC();
    (void)xcd_barrier_post((unsigned*)(as_global(p.k->ws) + OFF_CTL) + CW_BAR, bst);
#define GRID_BAR() do { XcdBarrier b_; b_.bar = (unsigned*)(as_global(p.k->ws) + OFF_CTL) + CW_BAR; b_.x = xb_xcc_id(); b_.st = (volatile LAS unsigned*)(lds + LDS_MISC + 256); xcd_barrier(b_, p.wv); } while (0)
    run_phase<PH_PREP>(p, 0, lds); WG_SYNC();
    run_phase<PH_MOD>(p, 0, lds); WG_SYNC();
    GRID_BAR();
    run_phase<PH_NORM0>(p, 0, lds);
    GRID_BAR();
#define LAYER(l) do { constexpr int kind = (l) % 3; \
        if constexpr (kind == 0) { run_phase<PH_S5>(p, l, lds); GRID_BAR(); run_phase<PH_GLU>(p, l, lds); GRID_BAR(); } \
        else if constexpr (kind == 1) { run_phase<PH_SCIN>(p, l, lds); GRID_BAR(); run_phase<PH_CONV3>(p, l, lds); GRID_BAR(); run_phase<PH_SCOUT>(p, l, lds); GRID_BAR(); } \
        else { run_phase<PH_PW1>(p, l, lds); GRID_BAR(); run_phase<PH_CONV31>(p, l, lds); GRID_BAR(); run_phase<PH_PW2>(p, l, lds); GRID_BAR(); } \
        run_phase<PH_ROUTE>(p, l, lds); GRID_BAR(); \
        run_phase<PH_MOE1>(p, l, lds); GRID_BAR(); \
        run_phase<PH_MOE2>(p, l, lds); GRID_BAR(); \
        run_phase<PH_COMBINE>(p, l, lds); \
        if constexpr ((l) + 1 < DEPTH) GRID_BAR(); } while (0)
    LAYER(0); LAYER(1); LAYER(2); LAYER(3);
#undef LAYER
#undef GRID_BAR
}
#endif

template <int PH> static void launch(const P& p, int l, int grid, hipStream_t s) {
    static bool attr = false;
    if (!attr) { (void)hipFuncSetAttribute((const void*)k_ph<PH>, hipFuncAttributeMaxDynamicSharedMemorySize, LDS_BYTES); attr = true; }
    hipLaunchKernelGGL(k_ph<PH>, dim3(grid), dim3(NTHR), LDS_BYTES, s, p, l);
}
extern "C" void kernel_launch(void* const* d_in, const int* in_sizes, int n_in, void* d_out, int out_size, void* d_ws, size_t ws_size, hipStream_t stream) {
    if (n_in != N_IN || ws_size < WS_END || out_size != RLAT * D) { fprintf(stderr, "kernel_launch: unexpected problem: n_in %d ws %zu out %d\n", n_in, ws_size, out_size); return; }
    P p{};
    for (int i = 0; i < N_IN; ++i) p.in[i] = (const float*)d_in[i];
    p.out = (float*)d_out; p.ws = (unsigned char*)d_ws;
    (void)hipMemsetAsync((char*)d_ws + OFF_CTL, 0, CTL_BYTES, stream);
#ifndef MK_MULTI
    static int grid = 0;
    if (!grid) {
        int dev = 0, cus = 0, per_cu = 0;
        (void)hipGetDevice(&dev); (void)hipDeviceGetAttribute(&cus, hipDeviceAttributeMultiprocessorCount, dev);
        (void)hipFuncSetAttribute((const void*)fwd, hipFuncAttributeMaxDynamicSharedMemorySize, LDS_BYTES);
        if (hipOccupancyMaxActiveBlocksPerMultiprocessor(&per_cu, (const void*)fwd, NTHR, LDS_BYTES) != hipSuccess || per_cu < 1) fprintf(stderr, "kernel_launch: occupancy query says %d blocks per CU\n", per_cu);
        (void)hipGetLastError();
        grid = cus >= 8 ? (cus & ~7) : 256;
    }
    hipLaunchKernelGGL(fwd, dim3(grid), dim3(NTHR), LDS_BYTES, stream, p);
    return;
#endif
    const int G = 256;
    launch<PH_PREP>(p, 0, G, stream);
    launch<PH_MOD>(p, 0, G, stream);
    launch<PH_NORM0>(p, 0, G, stream);
    for (int l = 0; l < DEPTH; ++l) {
        const int kind = l % 3;
        if (kind == 0) { launch<PH_S5>(p, l, G, stream); launch<PH_GLU>(p, l, G, stream); }
        else if (kind == 1) { launch<PH_SCIN>(p, l, G, stream); launch<PH_CONV3>(p, l, G, stream); launch<PH_SCOUT>(p, l, G, stream); }
        else { launch<PH_PW1>(p, l, G, stream); launch<PH_CONV31>(p, l, G, stream); launch<PH_PW2>(p, l, G, stream); }
        launch<PH_ROUTE>(p, l, G, stream);
        launch<PH_MOE1>(p, l, G, stream);
        launch<PH_MOE2>(p, l, G, stream);
        launch<PH_COMBINE>(p, l, G, stream);
    }
}
```

```cpp
#include <hip/hip_runtime.h>
#include <cstdio>
#include <cstdint>

#define LAS __attribute__((address_space(3)))
typedef unsigned short bf16_t;
typedef short bf16x8 __attribute__((ext_vector_type(8)));
typedef float f32x4 __attribute__((ext_vector_type(4)));
typedef float f32x2 __attribute__((ext_vector_type(2)));
typedef unsigned u32x4 __attribute__((ext_vector_type(4)));
typedef unsigned u32x2 __attribute__((ext_vector_type(2)));

constexpr int D = 1024, NBATCH = 4, SEQ = 4096, NCTX = 256, DEPTH = 4;
constexpr int RCTX = NBATCH * NCTX, RLAT = NBATCH * SEQ, RTOT = RCTX + RLAT;
constexpr int NE = 32, TOPK = 4, CAP = RTOT, MAXMT = 304;
constexpr int NTHR = 512, NWV = 8;
constexpr int LDS_BYTES = 157696, LDS_STAGE = 131072, LDS_MISC = 139264;

enum { I_X = 0, I_C, I_CTX, I_CCTX, I_ADAW, I_ADAB, I_N1G, I_N2G, I_FING, I_LRE, I_LIM, I_LDT, I_BRE, I_BIM, I_CRE, I_CIM, I_S5D, I_GLUW, I_GLUB,
       I_SCWIN, I_SCCW, I_SCWOUT, I_PW1W, I_PW1B, I_DWW, I_DWB, I_LNG, I_LNB, I_PW2W, I_PW2B, I_RW, I_RB, I_WGU, I_BGU, I_WD, I_BD, N_IN };

constexpr size_t MiB = 1u << 20;
constexpr size_t OFF_CTL = 0, CTL_BYTES = 1 * MiB;
constexpr size_t OFF_MOD = 1 * MiB, OFF_GATE = 2 * MiB, OFF_ELIST = 3 * MiB, OFF_BGUP = 6 * MiB, OFF_RWT = 7 * MiB;
constexpr size_t OFF_S5T = 7 * MiB + 512 * 1024;
constexpr size_t OFF_X = 8 * MiB, OFF_HN = 76 * MiB, OFF_A2 = 110 * MiB, OFF_F = 144 * MiB, OFF_Z = 178 * MiB;
constexpr size_t OFF_YF = 280 * MiB, OFF_YB = 348 * MiB, OFF_HM = 416 * MiB, OFF_Y = 568 * MiB;
constexpr size_t OFF_WT = 320 * MiB;
constexpr size_t OFF_KT = 280 * MiB, OFF_GT = 288 * MiB;
constexpr size_t OFF_WGLU = 704 * MiB, OFF_WSCIN = 712 * MiB, OFF_WSCOUT = 718 * MiB, OFF_WPW1 = 720 * MiB, OFF_WPW2 = 724 * MiB;
constexpr size_t OFF_WGU = 728 * MiB, OFF_WD = 1240 * MiB, WS_END = 1496 * MiB;
constexpr int CW_CNT = 64;
constexpr int CW_BAR = 4096;

struct P { const float* in[N_IN]; float* out; unsigned char* ws; };
typedef const __attribute__((address_space(4))) P* KP;
struct Cx { KP k; int wv; };
template <class T> __device__ __forceinline__ T* as_global(T* q) { return (T*)(__attribute__((address_space(1))) T*)q; }

#define WG_SYNC() do { __builtin_amdgcn_fence(__ATOMIC_RELEASE, "workgroup"); __builtin_amdgcn_s_barrier(); __builtin_amdgcn_fence(__ATOMIC_ACQUIRE, "workgroup"); } while (0)
typedef int i32x8 __attribute__((ext_vector_type(8)));
typedef int i32x4 __attribute__((ext_vector_type(4)));
__device__ __forceinline__ float sat8(float x) { return __builtin_fminf(__builtin_fmaxf(x, -448.f), 448.f); }
__device__ __forceinline__ unsigned pk4_fp8(float a, float b, float c, float d) { int r = 0; r = __builtin_amdgcn_cvt_pk_fp8_f32(a, b, r, false); r = __builtin_amdgcn_cvt_pk_fp8_f32(c, d, r, true); return (unsigned)r; }
__device__ __forceinline__ unsigned pk4_fp8_sat(float a, float b, float c, float d) { return pk4_fp8(sat8(a), sat8(b), sat8(c), sat8(d)); }
constexpr float W8_SCALE = 64.f, H8_SCALE = 4.f, Y8_SCALE = 16.f;
__device__ __forceinline__ int opaque_tid(int wv) { unsigned z = 0u; asm volatile("" : "+v"(z)); return wv * 64 + (int)__builtin_amdgcn_mbcnt_hi(~0u, __builtin_amdgcn_mbcnt_lo(~0u, z)); }
__device__ __forceinline__ float bf2f(unsigned b) { return __uint_as_float(b << 16); }
typedef __bf16 bf16x2_t __attribute__((ext_vector_type(2)));
__device__ __forceinline__ unsigned pk2(float lo, float hi) { const f32x2 v = {lo, hi}; return __builtin_bit_cast(unsigned, __builtin_convertvector(v, bf16x2_t)); }
__device__ __forceinline__ float sigm(float x) { return __builtin_amdgcn_rcpf(1.f + __expf(-x)); }
__device__ __forceinline__ float silu(float x) { return x * sigm(x); }
__device__ __forceinline__ float gelu_tanh(float x) { return x * sigm(1.5957691216f * (x + 0.044715f * x * x * x)); }
__device__ __forceinline__ float wave_sum(float v) {
#pragma unroll
    for (int o = 1; o < 64; o <<= 1) v += __shfl_xor(v, o);
    return v;
}
__device__ __forceinline__ int row_bi(int row) { return row < RCTX ? 4 : ((row - RCTX) >> 12); }
__device__ __forceinline__ void load_row(const float* r, int lane, f32x4 (&v)[4]) {
#pragma unroll
    for (int j = 0; j < 4; ++j) v[j] = *(const f32x4*)(r + 256 * j + 4 * lane);
}
__device__ __forceinline__ float row_sumsq(const f32x4 (&v)[4]) {
    float s = 0.f;
#pragma unroll
    for (int j = 0; j < 4; ++j) s += (v[j].x * v[j].x + v[j].y * v[j].y) + (v[j].z * v[j].z + v[j].w * v[j].w);
    return wave_sum(s);
}
__device__ __forceinline__ void norm_mod(const f32x4 (&v)[4], float rs, const float* g, const float* sc, const float* sh, int lane, f32x4 (&o)[4]) {
#pragma unroll
    for (int j = 0; j < 4; ++j) { const int col = 256 * j + 4 * lane;
        const f32x4 gg = *(const f32x4*)(g + col), s = *(const f32x4*)(sc + col), h = *(const f32x4*)(sh + col);
        o[j] = v[j] * rs * gg * (1.f + s) + h; }
}
__device__ __forceinline__ void store_row_bf16(bf16_t* dst, int lane, const f32x4 (&o)[4]) {
#pragma unroll
    for (int j = 0; j < 4; ++j) { u32x2 w; w.x = pk2(o[j].x, o[j].y); w.y = pk2(o[j].z, o[j].w); *(u32x2*)(dst + 256 * j + 4 * lane) = w; }
}
__device__ __forceinline__ void store_row_fp8(unsigned char* dst, int lane, const f32x4 (&o)[4]) {
#pragma unroll
    for (int j = 0; j < 4; ++j) *(unsigned*)(dst + 256 * j + 4 * lane) = pk4_fp8_sat(o[j].x, o[j].y, o[j].z, o[j].w);
}
__device__ __forceinline__ void store_row_s5(bf16_t* HNs, int row, int lane, const f32x4 (&o)[4]) {
    const int b = row < RCTX ? row >> 8 : (row - RCTX) >> 12, tok = row < RCTX ? row & 255 : NCTX + ((row - RCTX) & 4095);
#pragma unroll
    for (int j = 0; j < 4; ++j) { u32x2 w; w.x = pk2(o[j].x, o[j].y); w.y = pk2(o[j].z, o[j].w);
        *(u32x2*)(HNs + ((size_t)(b * 64 + 16 * j + (lane >> 2)) * (NCTX + SEQ) + tok) * 16 + (lane & 3) * 4) = w; }
}
__device__ __forceinline__ f32x4 ld_bf16x4(const bf16_t* p) { const u32x2 w = *(const u32x2*)p; return (f32x4){bf2f(w.x & 0xffffu), bf2f(w.x >> 16), bf2f(w.y & 0xffffu), bf2f(w.y >> 16)}; }
__device__ __forceinline__ void load_row_bf16(const bf16_t* r, int lane, f32x4 (&v)[4]) {
#pragma unroll
    for (int j = 0; j < 4; ++j) v[j] = ld_bf16x4(r + 256 * j + 4 * lane);
}


#define XB_TMO      128
#define XB_XCNT(j)  (256  + 64 * (j))
#define XB_XSUB(j)  (1280 + 64 * (j))
#define XB_XGEN(j)  (2304 + 64 * (j))
#define XB_TOP      3328
#define XB_TOPGEN   3392
#define XCD_BAR_WORDS 3456
#define XB_SPIN_CAP (1u << 18)

typedef __attribute__((address_space(1))) unsigned gu32;
__device__ __forceinline__ unsigned xb_ld(unsigned* p)              { return __hip_atomic_load((gu32*)p, __ATOMIC_RELAXED, __HIP_MEMORY_SCOPE_AGENT); }
__device__ __forceinline__ unsigned xb_add(unsigned* p, unsigned v) { return __hip_atomic_fetch_add((gu32*)p, v, __ATOMIC_RELAXED, __HIP_MEMORY_SCOPE_AGENT); }
__device__ __forceinline__ unsigned xb_xcc_id() { return (unsigned)__builtin_amdgcn_s_getreg((3 << 11) | 20) & 0xFu; }
#define XB_SPIN(cond, bar) do { unsigned _sp = 0; while (cond) { __builtin_amdgcn_s_sleep(1); \
    if ((++_sp & 255u) == 0u) { if (xb_ld(&(bar)[XB_TMO])) break; if (_sp > XB_SPIN_CAP) { xb_add(&(bar)[XB_TMO], 1u); break; } } } } while (0)

struct XcdBarrier {
    unsigned* bar; unsigned x;
    volatile LAS unsigned* st;
};
__device__ __forceinline__ XcdBarrier xcd_barrier_post(unsigned* bar, volatile LAS unsigned* st) {
    XcdBarrier b; b.bar = bar; b.x = xb_xcc_id(); b.st = st;
    if (threadIdx.x == 0) (void)xb_add(&as_global(bar)[XB_XCNT(b.x)], 1u);
    return b;
}
__device__ __forceinline__ void xcd_barrier_complete(unsigned* bar, unsigned x, unsigned& nloc, unsigned& nx) {
    const unsigned G = gridDim.x * gridDim.y * gridDim.z;
    unsigned sum, cnt, mine, sp = 0u;
    for (;;) {
        sum = 0u; cnt = 0u; mine = 0u;
#pragma unroll
        for (unsigned j = 0; j < 16; ++j) { const unsigned c = xb_ld(&bar[XB_XCNT(j)]); sum += c; cnt += (c > 0u) ? 1u : 0u; mine = (j == x) ? c : mine; }
        if (sum == G) break;
        __builtin_amdgcn_s_sleep(1);
        if ((++sp & 255u) == 0u) { if (xb_ld(&bar[XB_TMO])) break; if (sp > XB_SPIN_CAP) { xb_add(&bar[XB_TMO], 1u); break; } }
    }
    nloc = mine > 0u ? mine : 1u; nx = cnt > 0u ? cnt : 1u;
}
__device__ __forceinline__ void xcd_barrier(const XcdBarrier& b, int wv) {
    asm volatile("s_waitcnt vmcnt(0)" ::: "memory");
    WG_SYNC();
    if (opaque_tid(wv) == 0) {
        unsigned* bar = b.bar; asm volatile("" : "+s"(bar)); bar = as_global(bar);
        __builtin_amdgcn_s_waitcnt(0);
        unsigned nloc = b.st[0], nx = b.st[1];
        if (nloc == 0u) { xcd_barrier_complete(bar, b.x, nloc, nx); b.st[0] = nloc; b.st[1] = nx; }
        const unsigned old = xb_add(&bar[XB_XSUB(b.x)], 1u);
        const unsigned gen = old / nloc;
        if (old + 1u == (gen + 1u) * nloc) {
            __builtin_amdgcn_fence(__ATOMIC_RELEASE, "agent");
            asm volatile("s_waitcnt vmcnt(0)" ::: "memory");
            const unsigned og = xb_add(&bar[XB_TOP], 1u);
            const unsigned tg = og / nx;
            if (og + 1u == (tg + 1u) * nx) xb_add(&bar[XB_TOPGEN], 1u);
            else XB_SPIN(xb_ld(&bar[XB_TOPGEN]) == tg, bar);
            __builtin_amdgcn_fence(__ATOMIC_ACQUIRE, "agent");
            xb_add(&bar[XB_XGEN(b.x)], 1u);
            asm volatile("s_waitcnt vmcnt(0)" ::: "memory");
        } else {
            XB_SPIN(xb_ld(&bar[XB_XGEN(b.x)]) == gen, bar);
            __builtin_amdgcn_fence(__ATOMIC_ACQUIRE, "agent");
            asm volatile("s_waitcnt vmcnt(0)" ::: "memory");
        }
    }
    WG_SYNC();
}

__device__ __forceinline__ int tr_dst(int mode, int cb, int n) {
    if (mode == 0) return cb * 64 + n;
    if (mode == 3) {
        if (cb < 16) return 256 * (cb >> 1) + 64 * (cb & 1) + n;
        if (cb < 32) return 2048 + 64 * (cb - 16) + n;
        return 256 * ((cb - 32) >> 1) + 128 + 64 * (cb & 1) + n; }
    const int j0 = cb * 32, pn = j0 >> 7, jo = j0 & 127;
    if (mode == 1) return 256 * pn + 128 * (n >> 5) + jo + (n & 31);
    return 256 * pn + 128 * (n & 1) + jo + (n >> 1);
}
__device__ __forceinline__ int tr_src(int mode, int cb, int n, int N) {
    if (mode == 0) return cb * 64 + n;
    if (mode == 1) return (n >> 5) * (N >> 1) + cb * 32 + (n & 31);
    return cb * 64 + n;
}
__device__ __forceinline__ void tr_item(const float* W, int N, bf16_t* WT, int mode, int kb, int cb, LAS float* scr, int lane) {
    const int k0 = kb * 64; const int src = tr_src(mode, cb, lane, N);
#pragma unroll 16
    for (int kk = 0; kk < 64; ++kk) scr[kk * 65 + lane] = __builtin_nontemporal_load(W + (size_t)(k0 + kk) * N + src);
    asm volatile("s_waitcnt lgkmcnt(0)" ::: "memory");
    const int c = lane & 7;
#pragma unroll
    for (int j = 0; j < 8; ++j) { const int n = (lane >> 3) + 8 * j; const LAS float* s = scr + (8 * c) * 65 + n;
        u32x4 o; o.x = pk2(s[0], s[65]); o.y = pk2(s[2 * 65], s[3 * 65]); o.z = pk2(s[4 * 65], s[5 * 65]); o.w = pk2(s[6 * 65], s[7 * 65]);
        *(u32x4*)(WT + (size_t)tr_dst(mode, cb, n) * 1024 + k0 + 8 * c) = o; }
    asm volatile("s_waitcnt lgkmcnt(0)" ::: "memory");
}
__device__ __forceinline__ void tr_item8(const float* W, int N, unsigned char* WT, int mode, int kb, int cb, LAS float* scr, int lane) {
    const int k0 = kb * 64; const int src = tr_src(mode, cb, lane, N);
#pragma unroll 16
    for (int kk = 0; kk < 64; ++kk) scr[kk * 65 + lane] = __builtin_nontemporal_load(W + (size_t)(k0 + kk) * N + src);
    asm volatile("s_waitcnt lgkmcnt(0)" ::: "memory");
    const int c = lane & 3;
#pragma unroll
    for (int j = 0; j < 4; ++j) { const int n = (lane >> 2) + 16 * j; const LAS float* s = scr + (16 * c) * 65 + n;
        u32x4 o;
        o.x = pk4_fp8(s[0] * W8_SCALE, s[65] * W8_SCALE, s[2 * 65] * W8_SCALE, s[3 * 65] * W8_SCALE); o.y = pk4_fp8(s[4 * 65] * W8_SCALE, s[5 * 65] * W8_SCALE, s[6 * 65] * W8_SCALE, s[7 * 65] * W8_SCALE);
        o.z = pk4_fp8(s[8 * 65] * W8_SCALE, s[9 * 65] * W8_SCALE, s[10 * 65] * W8_SCALE, s[11 * 65] * W8_SCALE); o.w = pk4_fp8(s[12 * 65] * W8_SCALE, s[13 * 65] * W8_SCALE, s[14 * 65] * W8_SCALE, s[15 * 65] * W8_SCALE);
        *(u32x4*)(WT + (size_t)tr_dst(mode, cb, n) * 1024 + k0 + 16 * c) = o; }
    asm volatile("s_waitcnt lgkmcnt(0)" ::: "memory");
}
constexpr int MOE_ITEMS_GU = NE * 16 * 32, MOE_ITEMS = MOE_ITEMS_GU + NE * 16 * 16;
__device__ __forceinline__ void conv_moe_item(const Cx& p, int l, int I, LAS float* scr, int lane) {
    if (I < MOE_ITEMS_GU) { const int e = I >> 9, rr = I & 511, kb = rr >> 5, cb = rr & 31;
        tr_item8(as_global(p.k->in[I_WGU]) + (size_t)(l * NE + e) * 1024 * 2048, 2048, as_global(p.k->ws) + OFF_WGU + (size_t)(l * NE + e) * 2 * MiB, 2, kb, cb, scr, lane); }
    else { const int J = I - MOE_ITEMS_GU, e = J >> 8, rr = J & 255, kb = rr >> 4, cb = rr & 15;
        tr_item8(as_global(p.k->in[I_WD]) + (size_t)(l * NE + e) * 1024 * 1024, 1024, as_global(p.k->ws) + OFF_WD + (size_t)(l * NE + e) * 1 * MiB, 0, kb, cb, scr, lane); }
}
constexpr int TAIL_Q = 3;
__device__ __forceinline__ int tail_cap(int total, int G) { const int rounds = (total + G - 1) / G, rem = total - (rounds - 1) * G; return rem == G ? 0 : (G - rem) * NWV * TAIL_Q; }
__device__ __forceinline__ void tail_convert(const Cx& p, LAS unsigned char* lds, int lnext, int base, int total) {
    const int G = gridDim.x, c = blockIdx.x, rounds = (total + G - 1) / G, rem = total - (rounds - 1) * G;
    if (rem == G || c < rem) return;
    const int tid = opaque_tid(p.wv), lane = tid & 63, wave = p.wv; LAS float* scr = (LAS float*)(lds + wave * 16640);
    const int i0 = base + ((c - rem) * NWV + wave) * TAIL_Q;
#pragma unroll 1
    for (int k = 0; k < TAIL_Q; ++k) if (i0 + k < MOE_ITEMS) conv_moe_item(p, lnext, i0 + k, scr, lane);
}
__device__ __forceinline__ void conv_catchup(const Cx& p, LAS unsigned char* lds, int l, int covered) {
    const int tid = opaque_tid(p.wv), lane = tid & 63, wave = p.wv; LAS float* scr = (LAS float*)(lds + wave * 16640);
    for (int I = covered + blockIdx.x * NWV + wave; I < MOE_ITEMS; I += gridDim.x * NWV) conv_moe_item(p, l, I, scr, lane);
    WG_SYNC();
}
__device__ __forceinline__ void ph_prep(const Cx& p, LAS unsigned char* lds) {
    const int tid = opaque_tid(p.wv), lane = tid & 63, wave = tid >> 6;
    LAS float* scr = (LAS float*)(lds + wave * 16640);
    const int gw = blockIdx.x * NWV + wave, NGW = gridDim.x * NWV;
    constexpr int NJ = 7;
    const int jsrc[NJ] = {I_WGU, I_WD, I_GLUW, I_SCWIN, I_SCWOUT, I_PW1W, I_PW2W};
    const int jN[NJ] = {2048, 1024, 2048, 3072, 1024, 2048, 1024};
    const int jmode[NJ] = {2, 0, 1, 3, 0, 1, 0};
    const int jnmat[NJ] = {128, 128, 2, 1, 1, 1, 1};
    const size_t joff[NJ] = {OFF_WGU, OFF_WD, OFF_WGLU, OFF_WSCIN, OFF_WSCOUT, OFF_WPW1, OFF_WPW2};
    { LAS float* pw = (LAS float*)lds;
      LAS float* ql = pw + 4224; LAS float* cl = pw + 4352; LAS float* bl = pw + 6400;
      for (int item = blockIdx.x; item < 2 * 2 * 64; item += gridDim.x) {
          const int jd = item >> 6, g = item & 63, jj = jd >> 1, d = jd & 1;
          WG_SYNC();
          { const int n = tid & 63, eg = tid >> 6, i = (jd * 64 + g) * 64 + n; const float lre = as_global(p.k->in[I_LRE])[i], lim = as_global(p.k->in[I_LIM])[i], dt = __expf(as_global(p.k->in[I_LDT])[i >> 6]);
#pragma unroll 1
            for (int e = eg; e <= 32; e += 8) { const float er = expf(lre * dt * (float)e), ang = lim * dt * (float)e; pw[(e * 64 + n) * 2] = er * cosf(ang); pw[(e * 64 + n) * 2 + 1] = er * sinf(ang); }
            if (eg == 1) { const float er = expf(lre * dt), nr = er * cosf(lim * dt) - 1.f, ni = er * sinf(lim * dt), den = 1.f / (lre * lre + lim * lim);
                ql[n * 2] = (nr * lre + ni * lim) * den; ql[n * 2 + 1] = (ni * lre - nr * lim) * den; }
            const size_t cb0 = (size_t)(jd * 64 + g) * 1024;
#pragma unroll
            for (int q = 0; q < 2; ++q) { const int idx = tid + NTHR * q; cl[idx * 2] = as_global(p.k->in[I_CRE])[cb0 + idx]; cl[idx * 2 + 1] = as_global(p.k->in[I_CIM])[cb0 + idx];
                bl[idx * 2] = as_global(p.k->in[I_BRE])[cb0 + idx]; bl[idx * 2 + 1] = as_global(p.k->in[I_BIM])[cb0 + idx]; } }
          WG_SYNC();
          { const int pair = tid & 255, hq = pair >> 4, hp = pair & 15, lh = tid >> 8;
            unsigned short* kt = (unsigned short*)(as_global(p.k->ws) + OFF_KT + (size_t)((jj * 64 + g) * 2 + d) * 16896);
            float sacc[16];
#pragma unroll
            for (int q = 0; q < 16; ++q) sacc[q] = 0.f;
            if (lh == 0) kt[pair] = 0;
#pragma unroll 2
            for (int n = 0; n < 64; ++n) { const float qr = ql[n * 2], qi = ql[n * 2 + 1], br = bl[(n * 16 + hp) * 2], bi = bl[(n * 16 + hp) * 2 + 1], cr = cl[(hq * 64 + n) * 2], ci = cl[(hq * 64 + n) * 2 + 1];
                const float bbr = qr * br - qi * bi, bbi = qr * bi + qi * br, cbr = cr * bbr - ci * bbi, cbi = cr * bbi + ci * bbr;
#pragma unroll
                for (int q = 0; q < 16; ++q) { const int lg = 16 * lh + q; sacc[q] += cbr * pw[(lg * 64 + n) * 2] - cbi * pw[(lg * 64 + n) * 2 + 1]; } }
#pragma unroll
            for (int q = 0; q < 16; ++q) kt[(16 * lh + q + 1) * 256 + pair] = (unsigned short)(pk2(sacc[q], 0.f) & 0xffffu); }
          { const int t = tid >> 4, hq = tid & 15, e = d == 0 ? t + 1 : 32 - t, m = t >> 1, ii = (t & 1) * 16 + hq;
            unsigned char* gt = as_global(p.k->ws) + OFF_GT + (size_t)((jj * 64 + g) * 2 + d) * 131072;
#pragma unroll 4
            for (int n = 0; n < 64; ++n) { const float pr = pw[(e * 64 + n) * 2], pi = pw[(e * 64 + n) * 2 + 1], cr = cl[(hq * 64 + n) * 2], ci = cl[(hq * 64 + n) * 2 + 1];
                *(unsigned*)(gt + ((m * 8 + (n >> 3)) * 64 + ((n >> 2) & 1) * 32 + ii) * 16 + (n & 3) * 4) = pk2(cr * pr - ci * pi, -(cr * pi + ci * pr)); } }
          { const int ig = tid & 127, mt = ig >> 5, ii = ig & 31, st = 16 * mt + (ii >> 1), ri = ii & 1, hf = (tid >> 7) & 1, sg = tid >> 8;
            unsigned char* wt = as_global(p.k->ws) + OFF_WT + (size_t)((jj * 64 + g) * 2 + d) * 131072;
            const float qr = ql[st * 2], qi = ql[st * 2 + 1]; float bbr[8], bbi[8];
#pragma unroll
            for (int c = 0; c < 8; ++c) { const float br = bl[(st * 16 + 8 * hf + c) * 2], bi = bl[(st * 16 + 8 * hf + c) * 2 + 1]; bbr[c] = qr * br - qi * bi; bbi[c] = qr * bi + qi * br; }
#pragma unroll 2
            for (int s = 16 * sg; s < 16 * sg + 16; ++s) { const int e = d == 0 ? 31 - s : s; const float pr = pw[(e * 64 + st) * 2], pi = pw[(e * 64 + st) * 2 + 1]; float v[8];
#pragma unroll
                for (int c = 0; c < 8; ++c) v[c] = ri ? pr * bbi[c] + pi * bbr[c] : pr * bbr[c] - pi * bbi[c];
                u32x4 o; o.x = pk2(v[0], v[1]); o.y = pk2(v[2], v[3]); o.z = pk2(v[4], v[5]); o.w = pk2(v[6], v[7]);
                *(u32x4*)(wt + ((mt * 32 + s) * 64 + hf * 32 + ii) * 16) = o; } }
      }
      WG_SYNC(); }
    int base = 0;
#pragma unroll
    for (int j = 2; j < NJ; ++j) {
        const int N = jN[j], ncb = N / 64, ipm = 16 * ncb, tot = ipm * jnmat[j];
        const float* W0 = as_global(p.k->in[jsrc[j]]); bf16_t* T0 = (bf16_t*)(as_global(p.k->ws) + joff[j]);
        int first = gw - (base % NGW); if (first < 0) first += NGW;
        for (int it = first; it < tot; it += NGW) { const int mat = it / ipm, rr = it % ipm, kb = rr / ncb, cb = rr % ncb;
            if (j != 3) tr_item8(W0 + (size_t)mat * 1024 * N, N, (unsigned char*)T0 + (size_t)mat * N * 1024, jmode[j], kb, cb, scr, lane);
            else tr_item(W0 + (size_t)mat * 1024 * N, N, T0 + (size_t)mat * N * 1024, jmode[j], kb, cb, scr, lane); }
        base += tot;
    }
    { int first = gw - (base % NGW); if (first < 0) first += NGW;
      for (int I = first; I < MOE_ITEMS; I += NGW) conv_moe_item(p, 0, I, scr, lane); }
    { f32x4* tb = (f32x4*)(as_global(p.k->ws) + OFF_S5T);
      for (int i = blockIdx.x * NTHR + tid; i < 4 * 64 * 64; i += gridDim.x * NTHR) {
          const float lre = as_global(p.k->in[I_LRE])[i], lim = as_global(p.k->in[I_LIM])[i], dt = __expf(as_global(p.k->in[I_LDT])[i >> 6]);
          const float er = expf(lre * dt), lbr = er * cosf(lim * dt), lbi = er * sinf(lim * dt);
          const float nr = lbr - 1.f, ni = lbi, den = 1.f / (lre * lre + lim * lim);
          tb[i] = (f32x4){lbr, lbi, (nr * lre + ni * lim) * den, (ni * lre - nr * lim) * den}; } }
    { const float* rw = as_global(p.k->in[I_RW]); bf16_t* rt = (bf16_t*)(as_global(p.k->ws) + OFF_RWT);
      for (int i = blockIdx.x * NTHR + tid; i < DEPTH * NE * D; i += gridDim.x * NTHR) { const int k = i & 1023, e = (i >> 10) & 31, l = i >> 15;
          rt[i] = (bf16_t)(pk2(rw[((size_t)l * D + k) * NE + e], 0.f) & 0xffffu); } }
    { const float* bgu = as_global(p.k->in[I_BGU]); float* bp = (float*)(as_global(p.k->ws) + OFF_BGUP);
      for (int i = blockIdx.x * NTHR + tid; i < DEPTH * NE * 2048; i += gridDim.x * NTHR) {
          const int n = i & 2047, m = i >> 11, pn = n >> 8, s = (n >> 7) & 1, jj = n & 127;
          bp[i] = bgu[(size_t)m * 2048 + 2 * (128 * pn + jj) + s]; } }
}
__device__ __forceinline__ void ph_mod(const Cx& p, LAS unsigned char* lds) {
    const int tid = opaque_tid(p.wv), lane = tid & 63, wave = tid >> 6;
    LAS float* sc = (LAS float*)lds; LAS float* red = sc + 5 * 1024;
    for (int i = tid; i < 5 * 1024; i += NTHR) { const int bi = i >> 10, k = i & 1023; const float v = bi < 4 ? as_global(p.k->in[I_C])[bi * 1024 + k] : as_global(p.k->in[I_CCTX])[k]; sc[i] = silu(v); }
    WG_SYNC();
    float* mod = (float*)(as_global(p.k->ws) + OFF_MOD);
    for (int item = blockIdx.x; item < DEPTH * 48; item += gridDim.x) {
        const int l = item / 48, n0 = (item % 48) * 128;
        const float* W = as_global(p.k->in[I_ADAW]) + (size_t)l * 1024 * 6144 + n0 + lane * 2;
        float a[5][2];
#pragma unroll
        for (int b = 0; b < 5; ++b) { a[b][0] = 0.f; a[b][1] = 0.f; }
#pragma unroll 16
        for (int k = wave * 128; k < wave * 128 + 128; ++k) { const f32x2 w = __builtin_nontemporal_load((const f32x2*)(W + (size_t)k * 6144));
#pragma unroll
            for (int b = 0; b < 5; ++b) { const float s = sc[b * 1024 + k]; a[b][0] += s * w.x; a[b][1] += s * w.y; } }
#pragma unroll
        for (int b = 0; b < 5; ++b) { red[(wave * 5 + b) * 128 + lane * 2] = a[b][0]; red[(wave * 5 + b) * 128 + lane * 2 + 1] = a[b][1]; }
        WG_SYNC();
        for (int o = tid; o < 640; o += NTHR) { const int b = o >> 7, col = o & 127; float s = as_global(p.k->in[I_ADAB])[l * 6144 + n0 + col];
#pragma unroll
            for (int w = 0; w < 8; ++w) s += red[(w * 5 + b) * 128 + col];
            mod[(size_t)(l * 5 + b) * 6144 + n0 + col] = s; }
        WG_SYNC();
    }
}
__device__ __forceinline__ void ph_norm_first(const Cx& p) {
    const int tid = opaque_tid(p.wv), lane = tid & 63, wave = tid >> 6;
    bf16_t* X = (bf16_t*)(as_global(p.k->ws) + OFF_X); bf16_t* HN = (bf16_t*)(as_global(p.k->ws) + OFF_HN); const float* mod = (const float*)(as_global(p.k->ws) + OFF_MOD);
    for (int row = blockIdx.x * NWV + wave; row < RTOT; row += gridDim.x * NWV) {
        const float* src = row < RCTX ? as_global(p.k->in[I_CTX]) + (size_t)row * D : as_global(p.k->in[I_X]) + (size_t)(row - RCTX) * D;
        f32x4 v[4], o[4];
#pragma unroll
        for (int j = 0; j < 4; ++j) v[j] = __builtin_nontemporal_load((const f32x4*)(src + 256 * j + 4 * lane));
        store_row_bf16(X + (size_t)row * D, lane, v);
        const float rs = rsqrtf(row_sumsq(v) * (1.f / D) + 1e-6f);
        const float* m = mod + (size_t)(0 * 5 + row_bi(row)) * 6144;
        norm_mod(v, rs, as_global(p.k->in[I_N1G]), m + 1024, m, lane, o);
        store_row_s5(HN, row, lane, o);
    }
}

namespace g8 {
constexpr int BM = 256, BK = 64, HALF = 128, HTB = HALF * BK * 2;
__host__ __device__ __forceinline__ int lds_byte(int r, int c) { const int st = (r >> 4) * 2 + (c >> 5), rr = r & 15, cc = c & 31, ob = rr * 64 + cc * 2; return st * 1024 + (ob ^ (((ob >> 9) & 1) << 5)); }
__host__ __device__ __forceinline__ void stage_rc(int b, int& R, int& C) { const int st = b / 1024, sb = b % 1024, swz = sb ^ (((sb >> 9) & 1) << 5); R = (st >> 1) * 16 + swz / 64; C = (st & 1) * 32 + (swz % 64) / 2; }
__host__ __device__ __forceinline__ int perm32(int rho) { const int n = rho >> 4, i = rho & 15; return 8 * (i >> 2) + 4 * n + (i & 3); }

struct Unit { const char* B; int row0, pn, e, nvalid, lbase, bi, ui, rot; };
constexpr int MOE_TAB_UNITS = 14, MOE_MAX_UNITS = 16;
__device__ __forceinline__ KP fresh(KP k) { asm volatile("" : "+s"(k)); return k; }

template <int RB> struct SchedDenseT {
    KP k; size_t woff; int row_lo, nM, nN, G, c;
    __device__ __forceinline__ bool next(int i, Unit& u) const {
        const int L = i * G + c; if (L >= nM * nN) return false;
        const int pm = L / nN, pn = L % nN;
        u.B = (const char*)(as_global(fresh(k)->ws) + woff) + (size_t)pn * 256 * RB; u.row0 = row_lo + pm * 256; u.pn = pn; u.e = 0; u.nvalid = 256; u.lbase = 0; u.bi = row_bi(u.row0); u.ui = i; u.rot = 0; return true;
    }
    __device__ __forceinline__ unsigned aoff(const Unit& u, int, int r, int C) const { return (unsigned)(u.row0 + r) * (unsigned)RB + (unsigned)C * 2u; }
    static constexpr int ROWB = RB;
};
typedef SchedDenseT<2048> SchedDense;
typedef SchedDenseT<1024> SchedDense8;
struct SchedMoe {
    KP k; size_t woff, estride; const LAS int* desc; const LAS int* tab; int nu; bool gather;
    __device__ __forceinline__ bool next(int i, Unit& u) const {
        if (i >= nu) return false;
        const int e = __builtin_amdgcn_readfirstlane(desc[4 * i]), mg = __builtin_amdgcn_readfirstlane(desc[4 * i + 1]), nv = __builtin_amdgcn_readfirstlane(desc[4 * i + 2]), pr = __builtin_amdgcn_readfirstlane(desc[4 * i + 3]), pn = pr & 0xff;
        u.rot = pr >> 8; u.B = (const char*)(as_global(fresh(k)->ws) + woff) + (size_t)e * estride + (size_t)pn * 256 * ROWB; u.row0 = mg * 256; u.pn = pn; u.e = e; u.nvalid = nv & 0xffff; u.lbase = e * CAP + (nv >> 16) * 256; u.bi = 0; u.ui = i; return true;
    }
    __device__ __forceinline__ unsigned aoff(const Unit& u, int ui, int r, int C) const {
        if (gather) return (unsigned)tab[ui * 256 + r] + (unsigned)C * 2u;
        return (unsigned)(u.row0 + r) * (unsigned)ROWB + (unsigned)C * 2u;
    }
    static constexpr int ROWB = 1024;
};

struct EpiGluRes {
    static constexpr int PERM = 1;
    KP k; int l;
    __device__ __forceinline__ void operator()(const f32x4 (&acc)[2][2][4][2], const Unit& u, int wr, int wc, int fr, int fq) const {
        const KP kk = fresh(k); bf16_t* X = (bf16_t*)(as_global(kk->ws) + OFF_X); const float* bias = as_global(kk->in[I_GLUB]) + (l / 3) * 2048;
        const int j0 = u.pn * 128 + wc * 32 + 8 * fq; const float* g1 = (const float*)(as_global(kk->ws) + OFF_MOD) + (size_t)(l * 5 + u.bi) * 6144 + 2048;
        f32x4 ba[2], bg[2], gg[2];
#pragma unroll
        for (int n = 0; n < 2; ++n) { ba[n] = *(const f32x4*)(bias + j0 + 4 * n); bg[n] = *(const f32x4*)(bias + 1024 + j0 + 4 * n); gg[n] = *(const f32x4*)(g1 + j0 + 4 * n); }
#pragma unroll
        for (int ai = 0; ai < 2; ++ai)
#pragma unroll
            for (int m = 0; m < 4; ++m) { bf16_t* xp = X + (size_t)(u.row0 + ai * 128 + wr * 64 + m * 16 + fr) * D + j0;
                const u32x4 xw = *(const u32x4*)xp; const unsigned xs[4] = {xw.x, xw.y, xw.z, xw.w}; unsigned os[4];
#pragma unroll
                for (int n = 0; n < 2; ++n) { const f32x4 a = acc[ai][0][m][n] * (1.f / W8_SCALE) + ba[n], g = acc[ai][1][m][n] * (1.f / W8_SCALE) + bg[n];
                    f32x4 x = (f32x4){bf2f(xs[2 * n] & 0xffffu), bf2f(xs[2 * n] >> 16), bf2f(xs[2 * n + 1] & 0xffffu), bf2f(xs[2 * n + 1] >> 16)};
                    x.x += gg[n].x * a.x * sigm(g.x); x.y += gg[n].y * a.y * sigm(g.y); x.z += gg[n].z * a.z * sigm(g.z); x.w += gg[n].w * a.w * sigm(g.w);
                    os[2 * n] = pk2(x.x, x.y); os[2 * n + 1] = pk2(x.z, x.w); }
                *(u32x4*)xp = (u32x4){os[0], os[1], os[2], os[3]}; }
    }
};
struct EpiRes {
    static constexpr int PERM = 1;
    KP k; int l, bias_idx;
    __device__ __forceinline__ void operator()(const f32x4 (&acc)[2][2][4][2], const Unit& u, int wr, int wc, int fr, int fq) const {
        const KP kk = fresh(k); bf16_t* X = (bf16_t*)(as_global(kk->ws) + OFF_X); const float* bias = bias_idx >= 0 ? as_global(kk->in[bias_idx]) : nullptr;
        const int c0 = u.pn * 256 + wc * 32 + 8 * fq; const float* g1 = (const float*)(as_global(kk->ws) + OFF_MOD) + (size_t)(l * 5 + u.bi) * 6144 + 2048;
        f32x4 bv[2][2], gg[2][2];
#pragma unroll
        for (int bj = 0; bj < 2; ++bj)
#pragma unroll
            for (int n = 0; n < 2; ++n) { const int c = c0 + 128 * bj + 4 * n; bv[bj][n] = bias ? *(const f32x4*)(bias + c) : (f32x4){0.f, 0.f, 0.f, 0.f}; gg[bj][n] = *(const f32x4*)(g1 + c); }
#pragma unroll
        for (int ai = 0; ai < 2; ++ai)
#pragma unroll
            for (int m = 0; m < 4; ++m) { bf16_t* xp = X + (size_t)(u.row0 + ai * 128 + wr * 64 + m * 16 + fr) * D + c0;
#pragma unroll
                for (int bj = 0; bj < 2; ++bj) { const u32x4 xw = *(const u32x4*)(xp + 128 * bj); const unsigned xs[4] = {xw.x, xw.y, xw.z, xw.w}; unsigned os[4];
#pragma unroll
                    for (int n = 0; n < 2; ++n) { f32x4 x = (f32x4){bf2f(xs[2 * n] & 0xffffu), bf2f(xs[2 * n] >> 16), bf2f(xs[2 * n + 1] & 0xffffu), bf2f(xs[2 * n + 1] >> 16)};
                        x += gg[bj][n] * (acc[ai][bj][m][n] * (1.f / W8_SCALE) + bv[bj][n]); os[2 * n] = pk2(x.x, x.y); os[2 * n + 1] = pk2(x.z, x.w); }
                    *(u32x4*)(xp + 128 * bj) = (u32x4){os[0], os[1], os[2], os[3]}; } }
    }
};
struct EpiBf16 {
    static constexpr int PERM = 1;
    KP k; size_t ooff; int ldc; float dq;
    __device__ __forceinline__ void operator()(const f32x4 (&acc)[2][2][4][2], const Unit& u, int wr, int wc, int fr, int fq) const {
        bf16_t* O = (bf16_t*)(as_global(fresh(k)->ws) + ooff);
        const int c0 = u.pn * 256 + wc * 32 + 8 * fq;
#pragma unroll
        for (int ai = 0; ai < 2; ++ai)
#pragma unroll
            for (int m = 0; m < 4; ++m) { bf16_t* op = O + (size_t)(u.row0 + ai * 128 + wr * 64 + m * 16 + fr) * ldc + c0;
#pragma unroll
                for (int bj = 0; bj < 2; ++bj) { const f32x4 v0 = acc[ai][bj][m][0] * dq, v1 = acc[ai][bj][m][1] * dq;
                    u32x4 w; w.x = pk2(v0.x, v0.y); w.y = pk2(v0.z, v0.w); w.z = pk2(v1.x, v1.y); w.w = pk2(v1.z, v1.w); *(u32x4*)(op + 128 * bj) = w; } }
    }
};
struct EpiScin {
    static constexpr int PERM = 1;
    KP k;
    __device__ __forceinline__ void operator()(const f32x4 (&acc)[2][2][4][2], const Unit& u, int wr, int wc, int fr, int fq) const {
        bf16_t* O = (bf16_t*)(as_global(fresh(k)->ws) + OFF_Z);
        if (u.pn < 8) { const int j0 = u.pn * 128 + wc * 32 + 8 * fq;
#pragma unroll
            for (int ai = 0; ai < 2; ++ai)
#pragma unroll
                for (int m = 0; m < 4; ++m) { const f32x4 p0 = acc[ai][0][m][0] * acc[ai][1][m][0], p1 = acc[ai][0][m][1] * acc[ai][1][m][1];
                    u32x4 w; w.x = pk2(p0.x, p0.y); w.y = pk2(p0.z, p0.w); w.z = pk2(p1.x, p1.y); w.w = pk2(p1.z, p1.w);
                    *(u32x4*)(O + (size_t)(u.row0 + ai * 128 + wr * 64 + m * 16 + fr) * 2048 + j0) = w; }
        } else { const int c0 = 1024 + (u.pn - 8) * 256 + wc * 32 + 8 * fq;
#pragma unroll
            for (int ai = 0; ai < 2; ++ai)
#pragma unroll
                for (int m = 0; m < 4; ++m) { bf16_t* op = O + (size_t)(u.row0 + ai * 128 + wr * 64 + m * 16 + fr) * 2048 + c0;
#pragma unroll
                    for (int bj = 0; bj < 2; ++bj) { const f32x4 v0 = acc[ai][bj][m][0], v1 = acc[ai][bj][m][1];
                        u32x4 w; w.x = pk2(v0.x, v0.y); w.y = pk2(v0.z, v0.w); w.z = pk2(v1.x, v1.y); w.w = pk2(v1.z, v1.w); *(u32x4*)(op + 128 * bj) = w; } }
        }
    }
};
template <int ACT> struct EpiPairBf16 {
    static constexpr int PERM = 1;
    KP k; int l;
    __device__ __forceinline__ void operator()(const f32x4 (&acc)[2][2][4][2], const Unit& u, int wr, int wc, int fr, int fq) const {
        const KP kk = fresh(k);
        unsigned char* Ob = as_global(kk->ws) + (ACT == 0 ? OFF_Z : OFF_HM);
        const float* bb = ACT == 0 ? as_global(kk->in[I_PW1B]) : (const float*)(as_global(kk->ws) + OFF_BGUP) + (size_t)(l * NE + u.e) * 2048;
        const int j0 = u.pn * 128 + wc * 32 + 8 * fq;
        f32x4 ba[2], bg[2];
#pragma unroll
        for (int n = 0; n < 2; ++n) {
            if (ACT == 0) { ba[n] = *(const f32x4*)(bb + j0 + 4 * n); bg[n] = *(const f32x4*)(bb + 1024 + j0 + 4 * n); }
            else { const int q = u.pn * 256 + wc * 32 + 8 * fq + 4 * n; ba[n] = *(const f32x4*)(bb + q); bg[n] = *(const f32x4*)(bb + 128 + q); } }
#pragma unroll
        for (int ai = 0; ai < 2; ++ai)
#pragma unroll
            for (int m = 0; m < 4; ++m) { const size_t orow = (size_t)(u.row0 + ai * 128 + wr * 64 + m * 16 + fr);
                float r[8];
#pragma unroll
                for (int n = 0; n < 2; ++n) { const float dq = 1.f / W8_SCALE; const f32x4 a = acc[ai][0][m][n] * dq + ba[n], g = acc[ai][1][m][n] * dq + bg[n];
#pragma unroll
                    for (int q = 0; q < 4; ++q) {
                        if (ACT == 0) r[4 * n + q] = a[q] * sigm(g[q]);
                        else { const float gt = fminf(a[q], 7.0f), up = fminf(fmaxf(g[q], -7.0f), 7.0f);
                            const float rc = __builtin_amdgcn_rcpf(1.f + __builtin_amdgcn_exp2f(gt * (-1.702f * 1.44269504088896f))); r[4 * n + q] = (gt * rc) * __builtin_fmaf(up, H8_SCALE, H8_SCALE); } } }
                if (ACT == 0) { u32x4 w; w.x = pk2(r[0], r[1]); w.y = pk2(r[2], r[3]); w.z = pk2(r[4], r[5]); w.w = pk2(r[6], r[7]); *(u32x4*)(Ob + orow * 2048 + j0 * 2) = w; }
                else { u32x2 w; w.x = pk4_fp8(r[0], r[1], r[2], r[3]); w.y = pk4_fp8(r[4], r[5], r[6], r[7]); *(u32x2*)(Ob + orow * 1024 + j0) = w; } }
    }
};
struct EpiMoe2 {
    static constexpr int PERM = 2;
    KP k; int l; const LAS int* tflat; const LAS float* tgate;
    __device__ __forceinline__ void operator()(const f32x4 (&acc)[2][2][4][2], const Unit& u, int wr, int wc, int fr, int fq) const {
        const KP kk = fresh(k); unsigned char* Y = as_global(kk->ws) + OFF_Y;
        const int c0 = u.pn * 256 + wc * 64 + 16 * fq; const float* bb = as_global(kk->in[I_BD]) + (size_t)(l * NE + u.e) * D;
        f32x4 bv[2][2];
#pragma unroll
        for (int bj = 0; bj < 2; ++bj)
#pragma unroll
            for (int n = 0; n < 2; ++n) bv[bj][n] = *(const f32x4*)(bb + c0 + 8 * bj + 4 * n);
#pragma unroll
        for (int ai = 0; ai < 2; ++ai)
#pragma unroll
            for (int m = 0; m < 4; ++m) { const int r = ai * 128 + wr * 64 + m * 16 + fr;
                if (r < u.nvalid) { const int flat = tflat[u.ui * 256 + r]; const float gt = tgate[u.ui * 256 + r] * Y8_SCALE; const float dq = 1.f / (W8_SCALE * H8_SCALE);
                    const f32x4 v00 = (acc[ai][0][m][0] * dq + bv[0][0]) * gt, v01 = (acc[ai][0][m][1] * dq + bv[0][1]) * gt, v10 = (acc[ai][1][m][0] * dq + bv[1][0]) * gt, v11 = (acc[ai][1][m][1] * dq + bv[1][1]) * gt;
                    u32x4 w; w.x = pk4_fp8_sat(v00.x, v00.y, v00.z, v00.w); w.y = pk4_fp8_sat(v01.x, v01.y, v01.z, v01.w); w.z = pk4_fp8_sat(v10.x, v10.y, v10.z, v10.w); w.w = pk4_fp8_sat(v11.x, v11.y, v11.z, v11.w);
                    *(u32x4*)(Y + (size_t)flat * D + c0) = w; } }
    }
};

template <bool FP8> __device__ __forceinline__ f32x4 mma_one(const bf16x8& b0, const bf16x8& b1, const bf16x8& a0, const bf16x8& a1, const f32x4& c, int kk) {
    if constexpr (FP8) { const i32x4 bl = __builtin_bit_cast(i32x4, b0), bh = __builtin_bit_cast(i32x4, b1), al = __builtin_bit_cast(i32x4, a0), ah = __builtin_bit_cast(i32x4, a1);
        const i32x8 bv = __builtin_shufflevector(bl, bh, 0, 1, 2, 3, 4, 5, 6, 7), av = __builtin_shufflevector(al, ah, 0, 1, 2, 3, 4, 5, 6, 7);
        return __builtin_amdgcn_mfma_scale_f32_16x16x128_f8f6f4(bv, av, c, 0, 0, 0, 0, 0, 0); }
    else return __builtin_amdgcn_mfma_f32_16x16x32_bf16(kk ? b1 : b0, kk ? a1 : a0, c, 0, 0, 0);
}
template <class Epi, class Sched, bool FP8 = false>
__device__ __forceinline__ void gemm_phase(LAS unsigned char* lds, KP k, size_t a_off, const Sched& S, const Epi& E, int wv) {
    const char* Abase = (const char*)(as_global(fresh(k)->ws) + a_off);
    const int tid = opaque_tid(wv), wid = __builtin_amdgcn_readfirstlane(tid >> 6), lane = tid & 63, wr = wid >> 2, wc = wid & 3, fr = lane & 15, fq = lane >> 4;
    constexpr int ROWB = Sched::ROWB, nt = ROWB / 128, KOFF = 1024;
    static_assert(FP8 == (ROWB == 1024), "operand row pitch");
    int sR[2], sC[2]; unsigned voffB[2];
#pragma unroll
    for (int i = 0; i < 2; ++i) { stage_rc(tid * 16 + i * 8192, sR[i], sC[i]); const int Rb = Epi::PERM == 1 ? ((sR[i] & ~31) + perm32(sR[i] & 31)) : Epi::PERM == 2 ? 64 * (sR[i] >> 5) + 16 * ((sR[i] & 15) >> 2) + 4 * ((sR[i] >> 4) & 1) + (sR[i] & 3) : sR[i]; voffB[i] = (unsigned)(Rb * ROWB + sC[i] * 2); }
    constexpr size_t kstep = 128, hstep = (size_t)(Epi::PERM == 2 ? 8 : HALF) * ROWB;
    const unsigned ldsw = (unsigned)wid * 1024u;
    const int fcol = fq * 8;
    const int aoff = lds_byte(wr * 64 + fr, fcol), boff = lds_byte(wc * 32 + fr, fcol);
#define PG8_SA(b, h) (((b) * 2 + (h)) * HTB)
#define PG8_SB(b, h) ((4 + (b) * 2 + (h)) * HTB)
#define PG8_STAGE(bufoff, gbase, voff) do { _Pragma("unroll") for (int _i = 0; _i < 2; ++_i) \
        __builtin_amdgcn_global_load_lds((const unsigned*)((const char*)(gbase) + (voff)[_i]), (LAS unsigned*)(lds + (bufoff) + ldsw + _i * 8192), 16, 0, 0); } while (0)
#define PG8_LDA(dst, b, h) do { _Pragma("unroll") for (int m = 0; m < 4; ++m) _Pragma("unroll") for (int k = 0; k < 2; ++k) dst[m][k] = *(const LAS bf16x8*)(lds + PG8_SA(b, h) + aoff + m * 2048 + k * KOFF); } while (0)
#define PG8_LDB(dst, b, h) do { _Pragma("unroll") for (int n = 0; n < 2; ++n) _Pragma("unroll") for (int k = 0; k < 2; ++k) dst[n][k] = *(const LAS bf16x8*)(lds + PG8_SB(b, h) + boff + n * 2048 + k * KOFF); } while (0)
#define PG8_MMA(ai, bj, At, Bt) do { __builtin_amdgcn_s_setprio(1); _Pragma("unroll") for (int m = 0; m < 4; ++m) _Pragma("unroll") for (int n = 0; n < 2; ++n) _Pragma("unroll") for (int k = 0; k < (FP8 ? 1 : 2); ++k) \
        acc[ai][bj][m][n] = mma_one<FP8>(Bt[n][0], Bt[n][1], At[m][0], At[m][1], acc[ai][bj][m][n], k); __builtin_amdgcn_s_setprio(0); } while (0)
#define PG8_WAIT_V(n) asm volatile("s_waitcnt vmcnt(" #n ")" ::: "memory")
#define PG8_WAIT_L(n) asm volatile("s_waitcnt lgkmcnt(" #n ")" ::: "memory")
#define PG8_BAR __builtin_amdgcn_s_barrier()
#define PG8_SCHED __builtin_amdgcn_sched_barrier(0)
    Unit cur, nxt; int ui = 0;
    if (!S.next(0, cur)) return;
    f32x4 acc[2][2][4][2];
#pragma unroll
    for (int a = 0; a < 2; ++a)
#pragma unroll
        for (int b = 0; b < 2; ++b)
#pragma unroll
            for (int m = 0; m < 4; ++m)
#pragma unroll
                for (int n = 0; n < 2; ++n) acc[a][b][m][n] = (f32x4){0.f, 0.f, 0.f, 0.f};
    bf16x8 At[4][2], B0[2][2], B1[2][2];
    unsigned voffA[2][2];
#pragma unroll
    for (int h = 0; h < 2; ++h)
#pragma unroll
        for (int i = 0; i < 2; ++i) voffA[h][i] = S.aoff(cur, 0, h * 128 + sR[i], sC[i]);
    const char* cB = cur.B;
#define PG8_KT(j, rot) ((size_t)(((j) + (rot)) & (nt - 1)) * kstep)
    int crot = cur.rot;
    { const size_t k0 = PG8_KT(0, crot), k1 = PG8_KT(1, crot);
    PG8_STAGE(PG8_SB(0, 0), cB + k0, voffB); PG8_STAGE(PG8_SB(0, 1), cB + hstep + k0, voffB); PG8_STAGE(PG8_SA(0, 0), Abase + k0, voffA[0]); PG8_STAGE(PG8_SA(0, 1), Abase + k0, voffA[1]);
    if (wr == 1) PG8_BAR;
    PG8_WAIT_V(2); PG8_BAR;
    PG8_STAGE(PG8_SB(1, 0), cB + k1, voffB); PG8_STAGE(PG8_SA(1, 0), Abase + k1, voffA[0]); PG8_STAGE(PG8_SB(1, 1), cB + hstep + k1, voffB); }
    PG8_WAIT_V(6); PG8_BAR;
    for (;;) {
        const bool has_next = S.next(ui + 1, nxt);
        const char* nB = has_next ? nxt.B : cB; const int nrot = has_next ? nxt.rot : 0;
        for (int t = 0; t < nt; t += 2) {
            const bool last = (t == nt - 2);
            const size_t o1 = PG8_KT(t + 1, crot), o2 = last ? PG8_KT(0, nrot) : PG8_KT(t + 2, crot), o3 = last ? PG8_KT(1, nrot) : PG8_KT(t + 3, crot);
            const char* a1 = Abase + o1;
            const char* a2 = Abase + o2; const char* b2 = (last ? nB : cB) + o2;
            const char* a3 = Abase + o3; const char* b3 = (last ? nB : cB) + o3;
            PG8_LDB(B0, 0, 0); PG8_LDB(B1, 0, 1); PG8_SCHED; PG8_LDA(At, 0, 0); PG8_STAGE(PG8_SA(1, 1), a1, voffA[1]);
            if (last && has_next) {
#pragma unroll
                for (int h = 0; h < 2; ++h)
#pragma unroll
                    for (int i = 0; i < 2; ++i) voffA[h][i] = S.aoff(nxt, ui + 1, h * 128 + sR[i], sC[i]);
            }
            PG8_WAIT_V(8); PG8_WAIT_L(0); PG8_BAR; PG8_MMA(0, 0, At, B0); PG8_MMA(0, 1, At, B1); PG8_BAR; PG8_SCHED;
            PG8_LDA(At, 0, 1); PG8_STAGE(PG8_SB(0, 0), b2, voffB); PG8_STAGE(PG8_SB(0, 1), b2 + hstep, voffB); PG8_STAGE(PG8_SA(0, 0), a2, voffA[0]);
            PG8_WAIT_V(8); PG8_WAIT_L(0); PG8_BAR; PG8_MMA(1, 0, At, B0); PG8_MMA(1, 1, At, B1); PG8_BAR; PG8_SCHED;
            PG8_LDB(B0, 1, 0); PG8_LDB(B1, 1, 1); PG8_SCHED; PG8_LDA(At, 1, 0); PG8_STAGE(PG8_SA(0, 1), a2, voffA[1]);
            PG8_WAIT_V(8); PG8_WAIT_L(0); PG8_BAR; PG8_MMA(0, 0, At, B0); PG8_MMA(0, 1, At, B1); PG8_BAR; PG8_SCHED;
            PG8_LDA(At, 1, 1); PG8_STAGE(PG8_SB(1, 0), b3, voffB); PG8_STAGE(PG8_SB(1, 1), b3 + hstep, voffB); PG8_STAGE(PG8_SA(1, 0), a3, voffA[0]);
            PG8_WAIT_V(8); PG8_WAIT_L(0); PG8_BAR; PG8_MMA(1, 0, At, B0); PG8_MMA(1, 1, At, B1); PG8_BAR; PG8_SCHED;
        }
        if (wr == 0) PG8_BAR;
        E(acc, cur, wr, wc, fr, fq);
        if (!has_next) break;
#pragma unroll
        for (int a = 0; a < 2; ++a)
#pragma unroll
            for (int b = 0; b < 2; ++b)
#pragma unroll
                for (int m = 0; m < 4; ++m)
#pragma unroll
                    for (int n = 0; n < 2; ++n) acc[a][b][m][n] = (f32x4){0.f, 0.f, 0.f, 0.f};
        cur = nxt; cB = nB; crot = nrot; ++ui;
        if (wr == 1) PG8_BAR;
    }
    PG8_WAIT_V(0);
    PG8_BAR;
#undef PG8_KT
#undef PG8_SA
#undef PG8_SB
#undef PG8_STAGE
#undef PG8_LDA
#undef PG8_LDB
#undef PG8_MMA
#undef PG8_WAIT_V
#undef PG8_WAIT_L
#undef PG8_BAR
#undef PG8_SCHED
}
}

typedef float f32x16 __attribute__((ext_vector_type(16)));
__device__ __forceinline__ void s5_lam(const Cx& p, int jd, int g, int pp, float& lbr, float& lbi, float& qr, float& qi) {
    const f32x4 t = *(const f32x4*)(as_global(p.k->ws) + OFF_S5T + (size_t)((jd * 64 + g) * 64 + pp) * 16); lbr = t.x; lbi = t.y; qr = t.z; qi = t.w;
}
__device__ __forceinline__ int s5_tbi(int d, int B, int st) { return (d * 136 + B) * 64 + (st ^ ((B & 15) << 2)); }
__device__ __forceinline__ int s5_row(int b, int B, int t) { return B < 8 ? b * NCTX + 32 * B + t : RCTX + b * SEQ + 32 * (B - 8) + t; }
__device__ __forceinline__ void ph_s5(const Cx& p, int l, LAS unsigned char* lds) {
    const int tid = opaque_tid(p.wv), lane = tid & 63, wave = p.wv, n = lane & 31, h = lane >> 5, j = l / 3; const bool last = (l == DEPTH - 1);
    const bf16_t* HN = (const bf16_t*)(as_global(p.k->ws) + OFF_HN); bf16_t* A2 = (bf16_t*)(as_global(p.k->ws) + OFF_A2);
    LAS unsigned* Tb = (LAS unsigned*)lds;
    for (int wg = blockIdx.x; wg < NBATCH * 64; wg += gridDim.x) {
        const int tid = opaque_tid(p.wv), lane = tid & 63, n = lane & 31, h = lane >> 5;
        const int b = wg >> 6, g = wg & 63;
        const bf16_t* HNs = HN + (size_t)(b * 64 + g) * (NCTX + SEQ) * 16;
        float lbr[2], lbi[2];
#pragma unroll
        for (int d = 0; d < 2; ++d) { const int jd = j * 2 + d; float qr, qi; s5_lam(p, jd, g, lane, lbr[d], lbi[d], qr, qi); }
        WG_SYNC();
        {
            LAS unsigned char* Ub = lds + 69632;
            const int d = wave >> 2, mt = wave & 3;
            const unsigned char* WTg = as_global(p.k->ws) + OFF_WT + (size_t)((j * 64 + g) * 2 + d) * 131072;
            bf16x8 wf[32];
#pragma unroll
            for (int s = 0; s < 32; ++s) wf[s] = *(const bf16x8*)(WTg + ((mt * 32 + s) * 64 + lane) * 16);
            u32x4 uv[4];
#pragma unroll
            for (int q = 0; q < 4; ++q) { const int pc = tid + NTHR * q; uv[q] = *(const u32x4*)(HNs + (size_t)(pc >> 1) * 16 + 8 * (pc & 1)); }
#pragma unroll 1
            for (int nt = 0; nt < 5; ++nt) {
                WG_SYNC();
#pragma unroll
                for (int q = 0; q < 4; ++q) { const int pc = tid + NTHR * q, tk = pc >> 1, hf = pc & 1, nn = tk >> 5, s = tk & 31;
                    *(LAS u32x4*)(Ub + s * 1024 + ((nn ^ s) & 31) * 32 + hf * 16) = uv[q]; }
                WG_SYNC();
                if (nt < 4) {
#pragma unroll
                    for (int q = 0; q < 4; ++q) { const int pc = tid + NTHR * q, tok = 1024 * (nt + 1) + (pc >> 1);
                        uv[q] = (u32x4){0u, 0u, 0u, 0u}; if (tok < NCTX + SEQ) uv[q] = *(const u32x4*)(HNs + (size_t)tok * 16 + 8 * (pc & 1)); } }
                f32x16 e0, e1;
#pragma unroll
                for (int q = 0; q < 16; ++q) { e0[q] = 0.f; e1[q] = 0.f; }
#pragma unroll
                for (int s = 0; s < 32; s += 2) {
                    e0 = __builtin_amdgcn_mfma_f32_32x32x16_bf16(wf[s], *(const LAS bf16x8*)(Ub + s * 1024 + ((n ^ s) & 31) * 32 + h * 16), e0, 0, 0, 0);
                    e1 = __builtin_amdgcn_mfma_f32_32x32x16_bf16(wf[s + 1], *(const LAS bf16x8*)(Ub + (s + 1) * 1024 + ((n ^ (s + 1)) & 31) * 32 + h * 16), e1, 0, 0, 0); }
                const int B = 32 * nt + n;
                if (B < 136) {
#pragma unroll
                    for (int q = 0; q < 4; ++q) { u32x2 o; o.x = pk2(e0[4 * q] + e1[4 * q], e0[4 * q + 1] + e1[4 * q + 1]); o.y = pk2(e0[4 * q + 2] + e1[4 * q + 2], e0[4 * q + 3] + e1[4 * q + 3]);
                        *(LAS u32x2*)(Tb + (d * 136 + B) * 64 + 16 * mt + 4 * q + 2 * h) = o; } }
            }
        }
        WG_SYNC();
        if (wave < 2) { const int d = wave; float ar = lbr[d], ai = lbi[d];
#pragma unroll
            for (int q = 0; q < 5; ++q) { const float t2 = ar * ar - ai * ai; ai = 2.f * ar * ai; ar = t2; }
            float hr = 0.f, hi = 0.f;
#pragma unroll 1
            for (int i0 = 0; i0 < 136; i0 += 8) {
                unsigned e[8], o[8];
#pragma unroll
                for (int q = 0; q < 8; ++q) { const int i = i0 + q, B = d == 0 ? i : (i < 8 ? 7 - i : 143 - i); e[q] = Tb[(d * 136 + B) * 64 + lane]; }
#pragma unroll
                for (int q = 0; q < 8; ++q) { o[q] = pk2(hr, hi);
                    const float er = __uint_as_float(e[q] << 16), ei = __uint_as_float(e[q] & 0xffff0000u);
                    const float nr = ar * hr - ai * hi + er, ni = ar * hi + ai * hr + ei; hr = nr; hi = ni; }
#pragma unroll
                for (int q = 0; q < 8; ++q) { const int i = i0 + q, B = d == 0 ? i : (i < 8 ? 7 - i : 143 - i); Tb[(d * 136 + B) * 64 + lane] = o[q]; }
            }
        }
        WG_SYNC();
        {
            const int tid = opaque_tid(p.wv), lane = tid & 63, n = lane & 31, h = lane >> 5;
            for (int idx = tid; idx < 272 * 16; idx += NTHR) { const int row = idx >> 4, c = idx & 15, x = (row >= 136 ? row - 136 : row) & 15, c2 = c ^ x;
                if (c < c2) { LAS u32x4* pa = (LAS u32x4*)(Tb + row * 64 + c * 4); LAS u32x4* pb = (LAS u32x4*)(Tb + row * 64 + c2 * 4); const u32x4 va = *pa, vb = *pb; *pa = vb; *pb = va; } }
            LAS unsigned char* Ub = lds + 69632;
            LAS unsigned char* KTl = lds + 102400;
            { const unsigned char* KTg = as_global(p.k->ws) + OFF_KT + (size_t)(j * 64 + g) * 33792;
              for (int pc = tid; pc < 2112; pc += NTHR) *(LAS u32x4*)(KTl + pc * 16) = *(const u32x4*)(KTg + pc * 16); }
            const unsigned char* GTg = as_global(p.k->ws) + OFF_GT + (size_t)(j * 64 + g) * 262144;
            const int m0 = wave, m1 = 15 - wave, toff = n >> 4, hh = n & 15;
            bf16x8 gf[2][2][8];
#pragma unroll
            for (int d = 0; d < 2; ++d)
#pragma unroll
                for (int mi = 0; mi < 2; ++mi)
#pragma unroll
                    for (int ks = 0; ks < 8; ++ks) gf[d][mi][ks] = *(const bf16x8*)(GTg + d * 131072 + (((mi ? m1 : m0) * 8 + ks) * 64 + lane) * 16);
            const float* dd = as_global(p.k->in[I_S5D]) + j * D + 16 * g; const f32x4 dv0 = *(const f32x4*)(dd + 4 * h), dv1 = *(const f32x4*)(dd + 8 + 4 * h);
            const int offF = ((toff + 1) * 16 + hh) * 32 + h * 16, offR = ((34 - toff) * 16 + hh) * 32 + h * 16;
            unsigned char* A2b = (unsigned char*)A2;
            u32x4 uv[4];
#pragma unroll
            for (int q = 0; q < 4; ++q) { const int pc = tid + NTHR * q; uv[q] = *(const u32x4*)(HNs + (size_t)(pc >> 1) * 16 + 8 * (pc & 1)); }
#pragma unroll 1
            for (int nt = 0; nt < 5; ++nt) {
                WG_SYNC();
#pragma unroll
                for (int q = 0; q < 4; ++q) { const int pc = tid + NTHR * q, tk = pc >> 1, hf = pc & 1, nn = tk >> 5, s = tk & 31;
                    *(LAS u32x4*)(Ub + s * 1024 + ((nn ^ s) & 31) * 32 + hf * 16) = uv[q]; }
                WG_SYNC();
                f32x16 aF0, aF1;
#pragma unroll
                for (int q = 0; q < 16; ++q) { aF0[q] = 0.f; aF1[q] = 0.f; }
#pragma unroll 4
                for (int s = 0; s < 32; ++s) {
                    const bf16x8 bu = *(const LAS bf16x8*)(Ub + s * 1024 + ((n ^ s) & 31) * 32 + h * 16);
                    const int o0 = s <= 2 * m0 + 1 ? offF + (2 * m0 - s) * 512 : offR + (s - 2 * m0) * 512, o1 = s <= 2 * m1 + 1 ? offF + (2 * m1 - s) * 512 : offR + (s - 2 * m1) * 512;
                    aF0 = __builtin_amdgcn_mfma_f32_32x32x16_bf16(*(const LAS bf16x8*)(KTl + o0), bu, aF0, 0, 0, 0); aF1 = __builtin_amdgcn_mfma_f32_32x32x16_bf16(*(const LAS bf16x8*)(KTl + o1), bu, aF1, 0, 0, 0);
                }
#pragma unroll
                for (int e = 0; e < 2; ++e) { const int s0 = 2 * m0 + e, s1 = 2 * m1 + e;
                    const bf16x8 b0 = *(const LAS bf16x8*)(Ub + s0 * 1024 + ((n ^ s0) & 31) * 32 + h * 16), b1 = *(const LAS bf16x8*)(Ub + s1 * 1024 + ((n ^ s1) & 31) * 32 + h * 16);
                    const bf16x8 ar = *(const LAS bf16x8*)(KTl + offR + e * 512);
                    aF0 = __builtin_amdgcn_mfma_f32_32x32x16_bf16(ar, b0, aF0, 0, 0, 0); aF1 = __builtin_amdgcn_mfma_f32_32x32x16_bf16(ar, b1, aF1, 0, 0, 0); }
                const int Bc = min(32 * nt + n, 135);
#pragma unroll
                for (int ks = 0; ks < 8; ++ks) {
                    const bf16x8 h0 = *(const LAS bf16x8*)(Tb + s5_tbi(0, Bc, 8 * ks + 4 * h)), h1 = *(const LAS bf16x8*)(Tb + s5_tbi(1, Bc, 8 * ks + 4 * h));
                    aF0 = __builtin_amdgcn_mfma_f32_32x32x16_bf16(gf[0][0][ks], h0, aF0, 0, 0, 0); aF1 = __builtin_amdgcn_mfma_f32_32x32x16_bf16(gf[0][1][ks], h0, aF1, 0, 0, 0);
                    aF0 = __builtin_amdgcn_mfma_f32_32x32x16_bf16(gf[1][0][ks], h1, aF0, 0, 0, 0); aF1 = __builtin_amdgcn_mfma_f32_32x32x16_bf16(gf[1][1][ks], h1, aF1, 0, 0, 0);
                    if (ks & 1) __builtin_amdgcn_sched_barrier(0);
                }
                if (nt < 4) {
#pragma unroll
                    for (int q = 0; q < 4; ++q) { const int pc = tid + NTHR * q, tok = 1024 * (nt + 1) + (pc >> 1);
                        uv[q] = (u32x4){0u, 0u, 0u, 0u}; if (tok < NCTX + SEQ) uv[q] = *(const u32x4*)(HNs + (size_t)tok * 16 + 8 * (pc & 1)); } }
                {   LAS unsigned char* scr = lds + 140288 + wave * 2048;
#pragma unroll
                    for (int mi = 0; mi < 2; ++mi) { const int m = mi ? m1 : m0; const f32x16 y = mi ? aF1 : aF0;
#pragma unroll
                        for (int q4 = 0; q4 < 4; ++q4) { const int t = 2 * m + (q4 >> 1), c0 = 8 * (q4 & 1) + 4 * h;
                            const u32x2 uw = *(const LAS u32x2*)(Ub + t * 1024 + ((n ^ t) & 31) * 32 + c0 * 2); const f32x4 d4 = (q4 & 1) ? dv1 : dv0;
                            *(LAS unsigned*)(scr + ((mi * 2 + (q4 >> 1)) * 32 + n) * 16 + c0) = pk4_fp8_sat(gelu_tanh(y[4 * q4] + d4.x * bf2f(uw.x & 0xffffu)), gelu_tanh(y[4 * q4 + 1] + d4.y * bf2f(uw.x >> 16)),
                                                                                                              gelu_tanh(y[4 * q4 + 2] + d4.z * bf2f(uw.y & 0xffffu)), gelu_tanh(y[4 * q4 + 3] + d4.w * bf2f(uw.y >> 16))); } }
                    asm volatile("s_waitcnt lgkmcnt(0)" ::: "memory");
#pragma unroll
                    for (int k2 = 0; k2 < 2; ++k2) { const int sl = lane + 64 * k2, ti = sl >> 5, B = 32 * nt + (sl & 31), t = 2 * ((ti >> 1) ? m1 : m0) + (ti & 1);
                        const u32x4 o = *(const LAS u32x4*)(scr + sl * 16);
                        if (B < 136 && !(last && B < 8)) *(u32x4*)(A2b + (size_t)s5_row(b, B, t) * D + 16 * g) = o; }
                    asm volatile("s_waitcnt lgkmcnt(0)" ::: "memory");
                }
            }
        }
    }
}
__device__ __forceinline__ void ph_conv3(const Cx& p) {
    const bf16_t* Z = (const bf16_t*)(as_global(p.k->ws) + OFF_Z); bf16_t* A2 = (bf16_t*)(as_global(p.k->ws) + OFF_A2); const float* cw = as_global(p.k->in[I_SCCW]);
    const int tid = opaque_tid(p.wv);
    for (size_t i = (size_t)blockIdx.x * NTHR + tid; i < (size_t)RTOT * D / 4; i += (size_t)gridDim.x * NTHR) {
        const int row = (int)(i >> 8), col = (int)(i & 255) * 4;
        int pos, len; if (row < RCTX) { pos = row & 255; len = 256; } else { pos = (row - RCTX) & 63; len = 64; }
        f32x4 acc = (f32x4){0.f, 0.f, 0.f, 0.f};
#pragma unroll
        for (int d = 0; d < 3; ++d) { const int q = pos + d - 1; const bool ok = (q >= 0 && q < len);
            const bf16_t* zr = Z + (size_t)(ok ? row + d - 1 : row) * 2048; const f32x4 uu = ld_bf16x4(zr + col); f32x4 w = *(const f32x4*)(cw + d * D + col);
            if (!ok) w = (f32x4){0.f, 0.f, 0.f, 0.f};
            acc += w * uu; }
        const u32x2 gw = __builtin_nontemporal_load((const u32x2*)(Z + (size_t)row * 2048 + 1024 + col)); const f32x4 gb = (f32x4){bf2f(gw.x & 0xffffu), bf2f(gw.x >> 16), bf2f(gw.y & 0xffffu), bf2f(gw.y >> 16)}, o = gb * acc;
        *(unsigned*)((unsigned char*)A2 + (size_t)row * D + col) = pk4_fp8_sat(o.x, o.y, o.z, o.w);
    }
}
__device__ __forceinline__ void cf_ln_silu_store(const Cx& p, f32x4 (&a)[4], unsigned char* dst, int lane) {
    float s = 0.f;
#pragma unroll
    for (int j = 0; j < 4; ++j) s += (a[j].x + a[j].y) + (a[j].z + a[j].w);
    const float mu = wave_sum(s) * (1.f / D); float q2 = 0.f;
#pragma unroll
    for (int j = 0; j < 4; ++j) { a[j] = a[j] - mu; q2 += (a[j].x * a[j].x + a[j].y * a[j].y) + (a[j].z * a[j].z + a[j].w * a[j].w); }
    const float rstd = rsqrtf(wave_sum(q2) * (1.f / D) + 1e-5f);
    f32x4 o[4];
#pragma unroll
    for (int j = 0; j < 4; ++j) { const int col = 256 * j + 4 * lane; const f32x4 y = a[j] * rstd * *(const f32x4*)(as_global(p.k->in[I_LNG]) + col) + *(const f32x4*)(as_global(p.k->in[I_LNB]) + col);
        o[j] = (f32x4){silu(y.x), silu(y.y), silu(y.z), silu(y.w)}; }
    store_row_fp8(dst, lane, o);
}
__device__ __forceinline__ void ph_conv31(const Cx& p, LAS unsigned char* lds) {
    const int tid = opaque_tid(p.wv), lane = tid & 63, wave = p.wv;
    const bf16_t* U = (const bf16_t*)(as_global(p.k->ws) + OFF_Z); unsigned char* A2 = as_global(p.k->ws) + OFF_A2; bf16_t* T2 = (bf16_t*)(as_global(p.k->ws) + OFF_HN);
    const float* dw = as_global(p.k->in[I_DWW]);
    for (int item = blockIdx.x; item < NBATCH * 64; item += gridDim.x) {
        const int base = RCTX + (item >> 6) * SEQ + (item & 63);
        WG_SYNC();
#pragma unroll 4
        for (int q = 0; q < 16; ++q) { const int ch = tid + NTHR * q, r = ch >> 7, o16 = ch & 127;
            *(LAS u32x4*)(lds + r * 2048 + o16 * 16) = __builtin_nontemporal_load((const u32x4*)(U + (size_t)(base + 64 * r) * D + o16 * 8)); }
        WG_SYNC();
#pragma unroll 1
        for (int pass = 0; pass < 2; ++pass) {
            const int c0 = 128 * wave + 64 * pass + lane; const LAS unsigned char* col = lds + c0 * 2;
            float w0[31];
#pragma unroll
            for (int d = 0; d < 31; ++d) w0[d] = dw[d * D + c0];
            const float bb = as_global(p.k->in[I_DWB])[c0];
#pragma unroll 1
            for (int blk = 0; blk < 8; ++blk) {
                float in[38];
#pragma unroll
                for (int j = 0; j < 38; ++j) { const int rr = 8 * blk - 15 + j; const int rc = rr < 0 ? 0 : (rr > 63 ? 63 : rr);
                    const float v = __uint_as_float((unsigned)*(const LAS unsigned short*)(col + rc * 2048) << 16); in[j] = (rr >= 0 && rr < 64) ? v : 0.f; }
#pragma unroll
                for (int q = 0; q < 8; ++q) { float a0 = bb;
#pragma unroll
                    for (int d = 0; d < 31; ++d) a0 = fmaf(w0[d], in[q + d], a0);
                    *(unsigned short*)(T2 + (size_t)(base + 64 * (8 * blk + q)) * D + c0) = (unsigned short)(pk2(a0, 0.f) & 0xffffu); }
            }
        }
        asm volatile("s_waitcnt vmcnt(0)" ::: "memory");
        WG_SYNC();
        for (int r = wave; r < 64; r += NWV) { f32x4 a[4]; const bf16_t* pr = T2 + (size_t)(base + 64 * r) * D;
#pragma unroll
            for (int j = 0; j < 4; ++j) a[j] = ld_bf16x4(pr + 256 * j + 4 * lane);
            cf_ln_silu_store(p, a, A2 + (size_t)(base + 64 * r) * D, lane); }
    }
    for (int row = blockIdx.x * NWV + wave; row < RCTX; row += gridDim.x * NWV) {
        const int pos = row & 255, base = row - pos;
        f32x4 a[4];
#pragma unroll
        for (int j = 0; j < 4; ++j) a[j] = *(const f32x4*)(as_global(p.k->in[I_DWB]) + 256 * j + 4 * lane);
        for (int d = 0; d < 31; ++d) { const int q = pos + d - 15;
            if (q >= 0 && q < 256) { const bf16_t* ur = U + (size_t)(base + q) * D;
#pragma unroll
                for (int j = 0; j < 4; ++j) { const int col = 256 * j + 4 * lane; a[j] += *(const f32x4*)(dw + d * D + col) * ld_bf16x4(ur + col); } } }
        cf_ln_silu_store(p, a, A2 + (size_t)row * D, lane);
    }
}
__device__ __forceinline__ void ph_route(const Cx& p, int l, LAS unsigned char* lds) {
    const int tid = opaque_tid(p.wv), lane = tid & 63, wave = p.wv, n = lane & 31, h = lane >> 5;
    const bf16_t* X = (const bf16_t*)(as_global(p.k->ws) + OFF_X); bf16_t* F = (bf16_t*)(as_global(p.k->ws) + OFF_F); const float* mod = (const float*)(as_global(p.k->ws) + OFF_MOD);
    float* gate = (float*)(as_global(p.k->ws) + OFF_GATE); int* elist = (int*)(as_global(p.k->ws) + OFF_ELIST); unsigned* cnt = (unsigned*)(as_global(p.k->ws) + OFF_CTL) + CW_CNT + l * 32;
    const float* rb = as_global(p.k->in[I_RB]) + l * NE;
    constexpr int TS = 2064;
    LAS unsigned char* tile = lds;
    LAS float* part = (LAS float*)(lds + 32 * TS);
    LAS int* lcnt = (LAS int*)(lds + 32 * TS + 32768);
    LAS int* choice = lcnt + 64;
    const int row_lo = (l == DEPTH - 1) ? RCTX : 0, nrows = RTOT - row_lo, G = gridDim.x;
    const int per = (nrows + G - 1) / G, r0 = row_lo + blockIdx.x * per, r1 = min(r0 + per, RTOT);
    bf16x8 Bw[8];
    { const bf16_t* rt = (const bf16_t*)(as_global(p.k->ws) + OFF_RWT) + ((size_t)l * NE + n) * D + 128 * wave + 8 * h;
#pragma unroll
      for (int s = 0; s < 8; ++s) Bw[s] = *(const bf16x8*)(rt + 16 * s); }
    if (tid < 32) lcnt[tid] = 0;
    WG_SYNC();
    for (int rb0 = r0; rb0 < r1; rb0 += 32) {
        const int nb = min(32, r1 - rb0);
        for (int q = wave; q < 32; q += NWV) {
            if (q < nb) { const int row = rb0 + q; f32x4 v[4], f[4]; load_row_bf16(X + (size_t)row * D, lane, v);
                const float rs = rsqrtf(row_sumsq(v) * (1.f / D) + 1e-6f);
                const float* m = mod + (size_t)(l * 5 + row_bi(row)) * 6144;
                norm_mod(v, rs, as_global(p.k->in[I_N2G]) + l * D, m + 4096, m + 3072, lane, f);
#pragma unroll
                for (int j = 0; j < 4; ++j) { u32x2 w; w.x = pk2(f[j].x, f[j].y); w.y = pk2(f[j].z, f[j].w);
                    *(unsigned*)((unsigned char*)F + (size_t)row * D + 256 * j + 4 * lane) = pk4_fp8_sat(f[j].x, f[j].y, f[j].z, f[j].w); *(LAS u32x2*)(tile + q * TS + (256 * j + 4 * lane) * 2) = w; }
            } else {
#pragma unroll
                for (int j = 0; j < 4; ++j) *(LAS u32x2*)(tile + q * TS + (256 * j + 4 * lane) * 2) = (u32x2){0u, 0u};
            }
        }
        WG_SYNC();
        { f32x16 acc;
#pragma unroll
          for (int i = 0; i < 16; ++i) acc[i] = 0.f;
#pragma unroll
          for (int s = 0; s < 8; ++s) { const bf16x8 af = *(const LAS bf16x8*)(tile + n * TS + (128 * wave + 16 * s + 8 * h) * 2); acc = __builtin_amdgcn_mfma_f32_32x32x16_bf16(af, Bw[s], acc, 0, 0, 0); }
#pragma unroll
          for (int r = 0; r < 16; ++r) { const int t = (r & 3) + 8 * (r >> 2) + 4 * h; part[(wave * 32 + t) * 32 + n] = acc[r]; } }
        WG_SYNC();
        {
            const int rr = tid >> 4, sub = tid & 15;
            f32x2 s2 = *(const f32x2*)(rb + 2 * sub);
#pragma unroll
            for (int w = 0; w < 8; ++w) s2 += *(const LAS f32x2*)(part + (w * 32 + rr) * 32 + 2 * sub);
            float v0 = s2.x, v1 = s2.y, bv[4]; int bx[4];
#pragma unroll
            for (int k = 0; k < 4; ++k) { float cv = v1 > v0 ? v1 : v0; int ci = v1 > v0 ? 2 * sub + 1 : 2 * sub;
#pragma unroll
                for (int off = 1; off < 16; off <<= 1) { const float ov = __shfl_xor(cv, off); const int oi = __shfl_xor(ci, off); const bool better = ov > cv || (ov == cv && oi < ci); cv = better ? ov : cv; ci = better ? oi : ci; }
                bv[k] = cv; bx[k] = ci; if (ci == 2 * sub) v0 = -3.0e38f; if (ci == 2 * sub + 1) v1 = -3.0e38f; }
            if (sub == 0 && rr < nb) { const int row = rb0 + rr;
                const float e1 = __expf(bv[1] - bv[0]), e2 = __expf(bv[2] - bv[0]), e3 = __expf(bv[3] - bv[0]), inv = 1.f / (1.f + e1 + e2 + e3);
                *(f32x4*)(gate + (size_t)row * 4) = (f32x4){inv, e1 * inv, e2 * inv, e3 * inv};
#pragma unroll
                for (int k = 0; k < 4; ++k) { const int rank = __hip_atomic_fetch_add(lcnt + bx[k], 1, __ATOMIC_RELAXED, __HIP_MEMORY_SCOPE_WORKGROUP); choice[(row - r0) * 4 + k] = bx[k] | (rank << 8); } }
        }
        WG_SYNC();
    }
    if (tid < 32) { const int c = lcnt[tid]; lcnt[32 + tid] = c ? (int)atomicAdd(&cnt[tid], (unsigned)c) : 0; }
    WG_SYNC();
    for (int i = tid; i < (r1 - r0) * 4; i += NTHR) { const int c = choice[i], e = c & 0xff, rank = c >> 8; elist[e * CAP + lcnt[32 + e] + rank] = (r0 + (i >> 2)) * 4 + (i & 3); }
}
__device__ __forceinline__ void ph_combine(const Cx& p, int l) {
    const int tid = opaque_tid(p.wv), lane = tid & 63, wave = tid >> 6; const bool last = (l == DEPTH - 1);
    bf16_t* X = (bf16_t*)(as_global(p.k->ws) + OFF_X); bf16_t* HN = (bf16_t*)(as_global(p.k->ws) + OFF_HN); const bf16_t* Y = (const bf16_t*)(as_global(p.k->ws) + OFF_Y); const float* mod = (const float*)(as_global(p.k->ws) + OFF_MOD);
    const int row_lo = last ? RCTX : 0;
    for (int row = row_lo + blockIdx.x * NWV + wave; row < RTOT; row += gridDim.x * NWV) {
        f32x4 v[4], o[4]; load_row_bf16(X + (size_t)row * D, lane, v);
        const float* m = mod + (size_t)(l * 5 + row_bi(row)) * 6144;
#pragma unroll
        for (int j = 0; j < 4; ++j) { const int col = 256 * j + 4 * lane; const unsigned char* y = (const unsigned char*)Y + (size_t)row * 4 * D + col;
            f32x4 s = (f32x4){0.f, 0.f, 0.f, 0.f};
#pragma unroll
            for (int q = 0; q < 4; ++q) { const int w = __builtin_nontemporal_load((const int*)(y + q * D)); const f32x2 lo = __builtin_amdgcn_cvt_pk_f32_fp8(w, false), hi = __builtin_amdgcn_cvt_pk_f32_fp8(w, true); s += (f32x4){lo.x, lo.y, hi.x, hi.y}; }
            v[j] += *(const f32x4*)(m + 5120 + col) * (s * (1.f / Y8_SCALE)); }
        const float rs = rsqrtf(row_sumsq(v) * (1.f / D) + 1e-6f);
        if (last) {
            float* op = as_global(p.k->out) + (size_t)(row - RCTX) * D;
#pragma unroll
            for (int j = 0; j < 4; ++j) { const int col = 256 * j + 4 * lane; *(f32x4*)(op + col) = v[j] * rs * *(const f32x4*)(as_global(p.k->in[I_FING]) + col); }
        } else {
            store_row_bf16(X + (size_t)row * D, lane, v);
            const float* m2 = mod + (size_t)((l + 1) * 5 + row_bi(row)) * 6144;
            norm_mod(v, rs, as_global(p.k->in[I_N1G]) + (l + 1) * D, m2 + 1024, m2, lane, o);
            if ((l + 1) % 3 == 0) store_row_s5(HN, row, lane, o); else if ((l + 1) % 3 == 2) store_row_fp8((unsigned char*)HN + (size_t)row * D, lane, o);
            else store_row_bf16(HN + (size_t)row * D, lane, o);
        }
    }
}

__device__ __forceinline__ int moe_setup(const Cx& p, int l, LAS unsigned char* lds, int NTl, bool gather) {
    LAS int* pt = (LAS int*)(lds + LDS_MISC); LAS int* desc = (LAS int*)(lds + LDS_MISC + 512); LAS int* tab = (LAS int*)(lds + LDS_MISC + 1024);
    const int tid = opaque_tid(p.wv), G = gridDim.x, c = blockIdx.x;
    const int* cnt = (const int*)(as_global(p.k->ws) + OFF_CTL) + CW_CNT + l * 32; const int* elist = (const int*)(as_global(p.k->ws) + OFF_ELIST);
    WG_SYNC();
    if (tid == 0) { int s = 0; for (int e = 0; e < 32; ++e) { pt[e] = s; s += (cnt[e] + 255) >> 8; } pt[32] = s; }
    WG_SYNC();
    const int TMt = pt[32], S8 = G >> 3, x8 = c & 7, s8 = c >> 3, lo8 = (x8 * TMt) >> 3, ux = ((((x8 + 1) * TMt) >> 3) - lo8) * NTl;
    int nu = ux > s8 ? (ux - s8 + S8 - 1) / S8 : 0; if (nu > g8::MOE_MAX_UNITS) nu = g8::MOE_MAX_UNITS;
    if (tid < nu) { const int q = tid * S8 + s8, al = q / NTl, mg = lo8 + al; int pn = q % NTl; pn |= ((NTl == 8 ? pn + 2 * al : 2 * pn + al) & 7) << 8; int e = 0;
        for (int q = 1; q < 32; ++q) if (pt[q] <= mg) e = q;
        const int mt = mg - pt[e]; const int nv = min(256, cnt[e] - mt * 256);
        desc[4 * tid] = e; desc[4 * tid + 1] = mg; desc[4 * tid + 2] = nv | (mt << 16); desc[4 * tid + 3] = pn; }
    WG_SYNC();
    if (gather) {
        const int nt_ = nu < g8::MOE_TAB_UNITS ? nu : g8::MOE_TAB_UNITS;
        for (int i = tid; i < nt_ * 256; i += NTHR) { const int ui = i >> 8, r = i & 255; const int e = desc[4 * ui], nvm = desc[4 * ui + 2], nv = nvm & 0xffff, mt = nvm >> 16;
            tab[i] = r < nv ? (elist[e * CAP + mt * 256 + r] >> 2) * 1024 : 0; }
        if (nu > g8::MOE_TAB_UNITS) nu = g8::MOE_TAB_UNITS;
        WG_SYNC();
    } else {
        if (nu > 6) nu = 6;
        const float* gate = (const float*)(as_global(p.k->ws) + OFF_GATE); LAS float* tg = (LAS float*)(tab + 2048);
        for (int i = tid; i < nu * 256; i += NTHR) { const int ui = i >> 8, r = i & 255; const int e = desc[4 * ui], nvm = desc[4 * ui + 2], nv = nvm & 0xffff, mt = nvm >> 16;
            const int flat = r < nv ? elist[e * CAP + mt * 256 + r] : 0; tab[i] = flat; tg[i] = r < nv ? gate[flat] : 0.f; }
        WG_SYNC();
    }
    return __builtin_amdgcn_readfirstlane(nu);
}
enum { PH_PREP = 0, PH_MOD, PH_NORM0, PH_S5, PH_S5POST, PH_GLU, PH_SCIN, PH_CONV3, PH_SCOUT, PH_PW1, PH_CONV31, PH_PW2, PH_ROUTE, PH_MOE1, PH_MOE2, PH_COMBINE };

template <int PH> __device__ __forceinline__ void run_phase(const Cx& p_in, int l, LAS unsigned char* lds) {
    Cx p = p_in; asm volatile("" : "+s"(p.k));
    const int G = gridDim.x, c = blockIdx.x;
    if constexpr (PH == PH_PREP) ph_prep(p, lds);
    if constexpr (PH == PH_MOD) ph_mod(p, lds);
    if constexpr (PH == PH_NORM0) ph_norm_first(p);
    if constexpr (PH == PH_S5) ph_s5(p, l, lds);
    if constexpr (PH == PH_CONV3) ph_conv3(p);
    if constexpr (PH == PH_CONV31) ph_conv31(p, lds);
    if constexpr (PH == PH_ROUTE) { if (l > 0) { const int pk = (l - 1) % 3; const int covered = pk == 0 ? tail_cap(68 * 8, G) : pk == 1 ? tail_cap(68 * 12, G) + tail_cap(68 * 4, G) : tail_cap(68 * 8, G) + tail_cap(68 * 4, G);
            conv_catchup(p, lds, l, covered); }
        ph_route(p, l, lds); }
    if constexpr (PH == PH_COMBINE) ph_combine(p, l);
    if constexpr (PH == PH_GLU) { const bool last = (l == DEPTH - 1);
        g8::SchedDense8 S{p.k, OFF_WGLU + (size_t)(l / 3) * 2 * MiB, last ? RCTX : 0, last ? 64 : 68, 8, G, c}; g8::EpiGluRes E{p.k, l};
        g8::gemm_phase<g8::EpiGluRes, g8::SchedDense8, true>(lds, p.k, OFF_A2, S, E, p.wv);
        if (!last) tail_convert(p, lds, l + 1, 0, 68 * 8); }
    if constexpr (PH == PH_SCIN) { g8::SchedDense S{p.k, OFF_WSCIN, 0, 68, 12, G, c}; g8::EpiScin E{p.k}; g8::gemm_phase(lds, p.k, OFF_HN, S, E, p.wv); tail_convert(p, lds, l + 1, 0, 68 * 12); }
    if constexpr (PH == PH_SCOUT) { g8::SchedDense8 S{p.k, OFF_WSCOUT, 0, 68, 4, G, c}; g8::EpiRes E{p.k, l, -1}; g8::gemm_phase<g8::EpiRes, g8::SchedDense8, true>(lds, p.k, OFF_A2, S, E, p.wv); tail_convert(p, lds, l + 1, tail_cap(68 * 12, G), 68 * 4); }
    if constexpr (PH == PH_PW1) { g8::SchedDense8 S{p.k, OFF_WPW1, 0, 68, 8, G, c}; g8::EpiPairBf16<0> E{p.k, l}; g8::gemm_phase<g8::EpiPairBf16<0>, g8::SchedDense8, true>(lds, p.k, OFF_HN, S, E, p.wv); tail_convert(p, lds, l + 1, 0, 68 * 8); }
    if constexpr (PH == PH_PW2) { g8::SchedDense8 S{p.k, OFF_WPW2, 0, 68, 4, G, c}; g8::EpiRes E{p.k, l, I_PW2B}; g8::gemm_phase<g8::EpiRes, g8::SchedDense8, true>(lds, p.k, OFF_A2, S, E, p.wv); tail_convert(p, lds, l + 1, tail_cap(68 * 8, G), 68 * 4); }
    if constexpr (PH == PH_MOE1) { const int nu = moe_setup(p, l, lds, 8, true);
        g8::SchedMoe S{p.k, OFF_WGU + (size_t)l * 64 * MiB, (size_t)2 * MiB, (const LAS int*)(lds + LDS_MISC + 512), (const LAS int*)(lds + LDS_MISC + 1024), nu, true};
        g8::EpiPairBf16<1> E{p.k, l}; g8::gemm_phase<g8::EpiPairBf16<1>, g8::SchedMoe, true>(lds, p.k, OFF_F, S, E, p.wv); }
    if constexpr (PH == PH_MOE2) { const int nu = moe_setup(p, l, lds, 4, false);
        g8::SchedMoe S{p.k, OFF_WD + (size_t)l * 32 * MiB, (size_t)1 * MiB, (const LAS int*)(lds + LDS_MISC + 512), (const LAS int*)(lds + LDS_MISC + 1024), nu, false};
        g8::EpiMoe2 E{p.k, l, (const LAS int*)(lds + LDS_MISC + 1024), (const LAS float*)(lds + LDS_MISC + 1024 + 8192)}; g8::gemm_phase<g8::EpiMoe2, g8::SchedMoe, true>(lds, p.k, OFF_HM, S, E, p.wv); }
}

#define NO_PK_F32 __attribute__((target("no-packed-fp32-ops")))
template <int PH> __global__ void NO_PK_F32 __launch_bounds__(NTHR, 2) k_ph(P p0, int l) {
    extern __shared__ __attribute__((aligned(16))) unsigned char shm[];
    Cx p; p.k = (KP)__builtin_amdgcn_kernarg_segment_ptr(); p.wv = __builtin_amdgcn_readfirstlane(threadIdx.x >> 6);
    run_phase<PH>(p, l, (LAS unsigned char*)shm);
}
#ifndef MK_MULTI
__global__ void NO_PK_F32 __launch_bounds__(NTHR, 2) fwd(P p0) {
    extern __shared__ __attribute__((aligned(16))) unsigned char shm[];
    LAS unsigned char* lds = (LAS unsigned char*)shm;
    Cx p; p.k = (KP)__builtin_amdgcn_kernarg_segment_ptr(); p.wv = __builtin_amdgcn_readfirstlane(threadIdx.x >> 6);
    volatile LAS unsigned* bst = (volatile LAS unsigned*)(lds + LDS_MISC + 256);
    if (threadIdx.x == 0) { bst[0] = 0u; bst[1] = 0u; bst[2] = 0u; bst[3] = 0u; }
    WG_SYNC();
    (void)xcd_barrier_post((unsigned*)(as_global(p.k->ws) + OFF_CTL) + CW_BAR, bst);
#define GRID_BAR() do { XcdBarrier b_; b_.bar = (unsigned*)(as_global(p.k->ws) + OFF_CTL) + CW_BAR; b_.x = xb_xcc_id(); b_.st = (volatile LAS unsigned*)(lds + LDS_MISC + 256); xcd_barrier(b_, p.wv); } while (0)
    run_phase<PH_PREP>(p, 0, lds); WG_SYNC();
    run_phase<PH_MOD>(p, 0, lds); WG_SYNC();
    GRID_BAR();
    run_phase<PH_NORM0>(p, 0, lds);
    GRID_BAR();
#define LAYER(l) do { constexpr int kind = (l) % 3; \
        if constexpr (kind == 0) { run_phase<PH_S5>(p, l, lds); GRID_BAR(); run_phase<PH_GLU>(p, l, lds); GRID_BAR(); } \
        else if constexpr (kind == 1) { run_phase<PH_SCIN>(p, l, lds); GRID_BAR(); run_phase<PH_CONV3>(p, l, lds); GRID_BAR(); run_phase<PH_SCOUT>(p, l, lds); GRID_BAR(); } \
        else { run_phase<PH_PW1>(p, l, lds); GRID_BAR(); run_phase<PH_CONV31>(p, l, lds); GRID_BAR(); run_phase<PH_PW2>(p, l, lds); GRID_BAR(); } \
        run_phase<PH_ROUTE>(p, l, lds); GRID_BAR(); \
        run_phase<PH_MOE1>(p, l, lds); GRID_BAR(); \
        run_phase<PH_MOE2>(p, l, lds); GRID_BAR(); \
        run_phase<PH_COMBINE>(p, l, lds); \
        if constexpr ((l) + 1 < DEPTH) GRID_BAR(); } while (0)
    LAYER(0); LAYER(1); LAYER(2); LAYER(3);
#undef LAYER
#undef GRID_BAR
}
#endif

template <int PH> static void launch(const P& p, int l, int grid, hipStream_t s) {
    static bool attr = false;
    if (!attr) { (void)hipFuncSetAttribute((const void*)k_ph<PH>, hipFuncAttributeMaxDynamicSharedMemorySize, LDS_BYTES); attr = true; }
    hipLaunchKernelGGL(k_ph<PH>, dim3(grid), dim3(NTHR), LDS_BYTES, s, p, l);
}
extern "C" void kernel_launch(void* const* d_in, const int* in_sizes, int n_in, void* d_out, int out_size, void* d_ws, size_t ws_size, hipStream_t stream) {
    if (n_in != N_IN || ws_size < WS_END || out_size != RLAT * D) { fprintf(stderr, "kernel_launch: unexpected problem: n_in %d ws %zu out %d\n", n_in, ws_size, out_size); return; }
    P p{};
    for (int i = 0; i < N_IN; ++i) p.in[i] = (const float*)d_in[i];
    p.out = (float*)d_out; p.ws = (unsigned char*)d_ws;
    (void)hipMemsetAsync((char*)d_ws + OFF_CTL, 0, CTL_BYTES, stream);
#ifndef MK_MULTI
    static int grid = 0;
    if (!grid) {
        int dev = 0, cus = 0, per_cu = 0;
        (void)hipGetDevice(&dev); (void)hipDeviceGetAttribute(&cus, hipDeviceAttributeMultiprocessorCount, dev);
        (void)hipFuncSetAttribute((const void*)fwd, hipFuncAttributeMaxDynamicSharedMemorySize, LDS_BYTES);
        if (hipOccupancyMaxActiveBlocksPerMultiprocessor(&per_cu, (const void*)fwd, NTHR, LDS_BYTES) != hipSuccess || per_cu < 1) fprintf(stderr, "kernel_launch: occupancy query says %d blocks per CU\n", per_cu);
        (void)hipGetLastError();
        grid = cus >= 8 ? (cus & ~7) : 256;
    }
    hipLaunchKernelGGL(fwd, dim3(grid), dim3(NTHR), LDS_BYTES, stream, p);
    return;
#endif
    const int G = 256;
    launch<PH_PREP>(p, 0, G, stream);
    launch<PH_MOD>(p, 0, G, stream);
    launch<PH_NORM0>(p, 0, G, stream);
    for (int l = 0; l < DEPTH; ++l) {
        const int kind = l % 3;
        if (kind == 0) { launch<PH_S5>(p, l, G, stream); launch<PH_GLU>(p, l, G, stream); }
        else if (kind == 1) { launch<PH_SCIN>(p, l, G, stream); launch<PH_CONV3>(p, l, G, stream); launch<PH_SCOUT>(p, l, G, stream); }
        else { launch<PH_PW1>(p, l, G, stream); launch<PH_CONV31>(p, l, G, stream); launch<PH_PW2>(p, l, G, stream); }
        launch<PH_ROUTE>(p, l, G, stream);
        launch<PH_MOE1>(p, l, G, stream);
        launch<PH_MOE2>(p, l, G, stream);
        launch<PH_COMBINE>(p, l, G, stream);
    }
}
```

```cpp
#include <hip/hip_runtime.h>
#include <cstdio>
#include <cstdint>

#define LAS __attribute__((address_space(3)))
typedef unsigned short bf16_t;
typedef short bf16x8 __attribute__((ext_vector_type(8)));
typedef float f32x4 __attribute__((ext_vector_type(4)));
typedef float f32x2 __attribute__((ext_vector_type(2)));
typedef unsigned u32x4 __attribute__((ext_vector_type(4)));
typedef unsigned u32x2 __attribute__((ext_vector_type(2)));

constexpr int D = 1024, NBATCH = 4, SEQ = 4096, NCTX = 256, DEPTH = 4;
constexpr int RCTX = NBATCH * NCTX, RLAT = NBATCH * SEQ, RTOT = RCTX + RLAT;
constexpr int NE = 32, TOPK = 4, CAP = RTOT, MAXMT = 304;
constexpr int NTHR = 512, NWV = 8;
constexpr int LDS_BYTES = 157696, LDS_STAGE = 131072, LDS_MISC = 139264;

enum { I_X = 0, I_C, I_CTX, I_CCTX, I_ADAW, I_ADAB, I_N1G, I_N2G, I_FING, I_LRE, I_LIM, I_LDT, I_BRE, I_BIM, I_CRE, I_CIM, I_S5D, I_GLUW, I_GLUB,
       I_SCWIN, I_SCCW, I_SCWOUT, I_PW1W, I_PW1B, I_DWW, I_DWB, I_LNG, I_LNB, I_PW2W, I_PW2B, I_RW, I_RB, I_WGU, I_BGU, I_WD, I_BD, N_IN };

constexpr size_t MiB = 1u << 20;
constexpr size_t OFF_CTL = 0, CTL_BYTES = 1 * MiB;
constexpr size_t OFF_MOD = 1 * MiB, OFF_GATE = 2 * MiB, OFF_ELIST = 3 * MiB, OFF_BGUP = 6 * MiB, OFF_RWT = 7 * MiB;
constexpr size_t OFF_S5T = 7 * MiB + 512 * 1024;
constexpr size_t OFF_X = 8 * MiB, OFF_HN = 76 * MiB, OFF_A2 = 110 * MiB, OFF_F = 144 * MiB, OFF_Z = 178 * MiB;
constexpr size_t OFF_YF = 280 * MiB, OFF_YB = 348 * MiB, OFF_HM = 416 * MiB, OFF_Y = 568 * MiB;
constexpr size_t OFF_WT = 320 * MiB;
constexpr size_t OFF_KT = 280 * MiB, OFF_GT = 288 * MiB;
constexpr size_t OFF_WGLU = 704 * MiB, OFF_WSCIN = 712 * MiB, OFF_WSCOUT = 718 * MiB, OFF_WPW1 = 720 * MiB, OFF_WPW2 = 724 * MiB;
constexpr size_t OFF_WGU = 728 * MiB, OFF_WD = 1240 * MiB, WS_END = 1496 * MiB;
constexpr int CW_CNT = 64;
constexpr int CW_BAR = 4096;

struct P { const float* in[N_IN]; float* out; unsigned char* ws; };
typedef const __attribute__((address_space(4))) P* KP;
struct Cx { KP k; int wv; };
template <class T> __device__ __forceinline__ T* as_global(T* q) { return (T*)(__attribute__((address_space(1))) T*)q; }

#define WG_SYNC() do { __builtin_amdgcn_fence(__ATOMIC_RELEASE, "workgroup"); __builtin_amdgcn_s_barrier(); __builtin_amdgcn_fence(__ATOMIC_ACQUIRE, "workgroup"); } while (0)
typedef int i32x8 __attribute__((ext_vector_type(8)));
typedef int i32x4 __attribute__((ext_vector_type(4)));
__device__ __forceinline__ float sat8(float x) { return __builtin_fminf(__builtin_fmaxf(x, -448.f), 448.f); }
__device__ __forceinline__ unsigned pk4_fp8(float a, float b, float c, float d) { int r = 0; r = __builtin_amdgcn_cvt_pk_fp8_f32(a, b, r, false); r = __builtin_amdgcn_cvt_pk_fp8_f32(c, d, r, true); return (unsigned)r; }
__device__ __forceinline__ unsigned pk4_fp8_sat(float a, float b, float c, float d) { return pk4_fp8(sat8(a), sat8(b), sat8(c), sat8(d)); }
constexpr float W8_SCALE = 64.f, H8_SCALE = 4.f, Y8_SCALE = 16.f;
__device__ __forceinline__ int opaque_tid(int wv) { unsigned z = 0u; asm volatile("" : "+v"(z)); return wv * 64 + (int)__builtin_amdgcn_mbcnt_hi(~0u, __builtin_amdgcn_mbcnt_lo(~0u, z)); }
__device__ __forceinline__ float bf2f(unsigned b) { return __uint_as_float(b << 16); }
typedef __bf16 bf16x2_t __attribute__((ext_vector_type(2)));
__device__ __forceinline__ unsigned pk2(float lo, float hi) { const f32x2 v = {lo, hi}; return __builtin_bit_cast(unsigned, __builtin_convertvector(v, bf16x2_t)); }
__device__ __forceinline__ float sigm(float x) { return __builtin_amdgcn_rcpf(1.f + __expf(-x)); }
__device__ __forceinline__ float silu(float x) { return x * sigm(x); }
__device__ __forceinline__ float gelu_tanh(float x) { return x * sigm(1.5957691216f * (x + 0.044715f * x * x * x)); }
__device__ __forceinline__ float wave_sum(float v) {
#pragma unroll
    for (int o = 1; o < 64; o <<= 1) v += __shfl_xor(v, o);
    return v;
}
__device__ __forceinline__ int row_bi(int row) { return row < RCTX ? 4 : ((row - RCTX) >> 12); }
__device__ __forceinline__ void load_row(const float* r, int lane, f32x4 (&v)[4]) {
#pragma unroll
    for (int j = 0; j < 4; ++j) v[j] = *(const f32x4*)(r + 256 * j + 4 * lane);
}
__device__ __forceinline__ float row_sumsq(const f32x4 (&v)[4]) {
    float s = 0.f;
#pragma unroll
    for (int j = 0; j < 4; ++j) s += (v[j].x * v[j].x + v[j].y * v[j].y) + (v[j].z * v[j].z + v[j].w * v[j].w);
    return wave_sum(s);
}
__device__ __forceinline__ void norm_mod(const f32x4 (&v)[4], float rs, const float* g, const float* sc, const float* sh, int lane, f32x4 (&o)[4]) {
#pragma unroll
    for (int j = 0; j < 4; ++j) { const int col = 256 * j + 4 * lane;
        const f32x4 gg = *(const f32x4*)(g + col), s = *(const f32x4*)(sc + col), h = *(const f32x4*)(sh + col);
        o[j] = v[j] * rs * gg * (1.f + s) + h; }
}
__device__ __forceinline__ void store_row_bf16(bf16_t* dst, int lane, const f32x4 (&o)[4]) {
#pragma unroll
    for (int j = 0; j < 4; ++j) { u32x2 w; w.x = pk2(o[j].x, o[j].y); w.y = pk2(o[j].z, o[j].w); *(u32x2*)(dst + 256 * j + 4 * lane) = w; }
}
__device__ __forceinline__ void store_row_fp8(unsigned char* dst, int lane, const f32x4 (&o)[4]) {
#pragma unroll
    for (int j = 0; j < 4; ++j) *(unsigned*)(dst + 256 * j + 4 * lane) = pk4_fp8_sat(o[j].x, o[j].y, o[j].z, o[j].w);
}
__device__ __forceinline__ void store_row_s5(bf16_t* HNs, int row, int lane, const f32x4 (&o)[4]) {
    const int b = row < RCTX ? row >> 8 : (row - RCTX) >> 12, tok = row < RCTX ? row & 255 : NCTX + ((row - RCTX) & 4095);
#pragma unroll
    for (int j = 0; j < 4; ++j) { u32x2 w; w.x = pk2(o[j].x, o[j].y); w.y = pk2(o[j].z, o[j].w);
        *(u32x2*)(HNs + ((size_t)(b * 64 + 16 * j + (lane >> 2)) * (NCTX + SEQ) + tok) * 16 + (lane & 3) * 4) = w; }
}
__device__ __forceinline__ f32x4 ld_bf16x4(const bf16_t* p) { const u32x2 w = *(const u32x2*)p; return (f32x4){bf2f(w.x & 0xffffu), bf2f(w.x >> 16), bf2f(w.y & 0xffffu), bf2f(w.y >> 16)}; }
__device__ __forceinline__ void load_row_bf16(const bf16_t* r, int lane, f32x4 (&v)[4]) {
#pragma unroll
    for (int j = 0; j < 4; ++j) v[j] = ld_bf16x4(r + 256 * j + 4 * lane);
}


#define XB_TMO      128
#define XB_XCNT(j)  (256  + 64 * (j))
#define XB_XSUB(j)  (1280 + 64 * (j))
#define XB_XGEN(j)  (2304 + 64 * (j))
#define XB_TOP      3328
#define XB_TOPGEN   3392
#define XCD_BAR_WORDS 3456
#define XB_SPIN_CAP (1u << 18)

typedef __attribute__((address_space(1))) unsigned gu32;
__device__ __forceinline__ unsigned xb_ld(unsigned* p)              { return __hip_atomic_load((gu32*)p, __ATOMIC_RELAXED, __HIP_MEMORY_SCOPE_AGENT); }
__device__ __forceinline__ unsigned xb_add(unsigned* p, unsigned v) { return __hip_atomic_fetch_add((gu32*)p, v, __ATOMIC_RELAXED, __HIP_MEMORY_SCOPE_AGENT); }
__device__ __forceinline__ unsigned xb_xcc_id() { return (unsigned)__builtin_amdgcn_s_getreg((3 << 11) | 20) & 0xFu; }
#define XB_SPIN(cond, bar) do { unsigned _sp = 0; while (cond) { __builtin_amdgcn_s_sleep(1); \
    if ((++_sp & 255u) == 0u) { if (xb_ld(&(bar)[XB_TMO])) break; if (_sp > XB_SPIN_CAP) { xb_add(&(bar)[XB_TMO], 1u); break; } } } } while (0)

struct XcdBarrier {
    unsigned* bar; unsigned x;
    volatile LAS unsigned* st;
};
__device__ __forceinline__ XcdBarrier xcd_barrier_post(unsigned* bar, volatile LAS unsigned* st) {
    XcdBarrier b; b.bar = bar; b.x = xb_xcc_id(); b.st = st;
    if (threadIdx.x == 0) (void)xb_add(&as_global(bar)[XB_XCNT(b.x)], 1u);
    return b;
}
__device__ __forceinline__ void xcd_barrier_complete(unsigned* bar, unsigned x, unsigned& nloc, unsigned& nx) {
    const unsigned G = gridDim.x * gridDim.y * gridDim.z;
    unsigned sum, cnt, mine, sp = 0u;
    for (;;) {
        sum = 0u; cnt = 0u; mine = 0u;
#pragma unroll
        for (unsigned j = 0; j < 16; ++j) { const unsigned c = xb_ld(&bar[XB_XCNT(j)]); sum += c; cnt += (c > 0u) ? 1u : 0u; mine = (j == x) ? c : mine; }
        if (sum == G) break;
        __builtin_amdgcn_s_sleep(1);
        if ((++sp & 255u) == 0u) { if (xb_ld(&bar[XB_TMO])) break; if (sp > XB_SPIN_CAP) { xb_add(&bar[XB_TMO], 1u); break; } }
    }
    nloc = mine > 0u ? mine : 1u; nx = cnt > 0u ? cnt : 1u;
}
__device__ __forceinline__ void xcd_barrier(const XcdBarrier& b, int wv) {
    asm volatile("s_waitcnt vmcnt(0)" ::: "memory");
    WG_SYNC();
    if (opaque_tid(wv) == 0) {
        unsigned* bar = b.bar; asm volatile("" : "+s"(bar)); bar = as_global(bar);
        __builtin_amdgcn_s_waitcnt(0);
        unsigned nloc = b.st[0], nx = b.st[1];
        if (nloc == 0u) { xcd_barrier_complete(bar, b.x, nloc, nx); b.st[0] = nloc; b.st[1] = nx; }
        const unsigned old = xb_add(&bar[XB_XSUB(b.x)], 1u);
        const unsigned gen = old / nloc;
        if (old + 1u == (gen + 1u) * nloc) {
            __builtin_amdgcn_fence(__ATOMIC_RELEASE, "agent");
            asm volatile("s_waitcnt vmcnt(0)" ::: "memory");
            const unsigned og = xb_add(&bar[XB_TOP], 1u);
            const unsigned tg = og / nx;
            if (og + 1u == (tg + 1u) * nx) xb_add(&bar[XB_TOPGEN], 1u);
            else XB_SPIN(xb_ld(&bar[XB_TOPGEN]) == tg, bar);
            __builtin_amdgcn_fence(__ATOMIC_ACQUIRE, "agent");
            xb_add(&bar[XB_XGEN(b.x)], 1u);
            asm volatile("s_waitcnt vmcnt(0)" ::: "memory");
        } else {
            XB_SPIN(xb_ld(&bar[XB_XGEN(b.x)]) == gen, bar);
            __builtin_amdgcn_fence(__ATOMIC_ACQUIRE, "agent");
            asm volatile("s_waitcnt vmcnt(0)" ::: "memory");
        }
    }
    WG_SYNC();
}

__device__ __forceinline__ int tr_dst(int mode, int cb, int n) {
    if (mode == 0) return cb * 64 + n;
    if (mode == 3) {
        if (cb < 16) return 256 * (cb >> 1) + 64 * (cb & 1) + n;
        if (cb < 32) return 2048 + 64 * (cb - 16) + n;
        return 256 * ((cb - 32) >> 1) + 128 + 64 * (cb & 1) + n; }
    const int j0 = cb * 32, pn = j0 >> 7, jo = j0 & 127;
    if (mode == 1) return 256 * pn + 128 * (n >> 5) + jo + (n & 31);
    return 256 * pn + 128 * (n & 1) + jo + (n >> 1);
}
__device__ __forceinline__ int tr_src(int mode, int cb, int n, int N) {
    if (mode == 0) return cb * 64 + n;
    if (mode == 1) return (n >> 5) * (N >> 1) + cb * 32 + (n & 31);
    return cb * 64 + n;
}
__device__ __forceinline__ void tr_item(const float* W, int N, bf16_t* WT, int mode, int kb, int cb, LAS float* scr, int lane) {
    const int k0 = kb * 64; const int src = tr_src(mode, cb, lane, N);
#pragma unroll 16
    for (int kk = 0; kk < 64; ++kk) scr[kk * 65 + lane] = __builtin_nontemporal_load(W + (size_t)(k0 + kk) * N + src);
    asm volatile("s_waitcnt lgkmcnt(0)" ::: "memory");
    const int c = lane & 7;
#pragma unroll
    for (int j = 0; j < 8; ++j) { const int n = (lane >> 3) + 8 * j; const LAS float* s = scr + (8 * c) * 65 + n;
        u32x4 o; o.x = pk2(s[0], s[65]); o.y = pk2(s[2 * 65], s[3 * 65]); o.z = pk2(s[4 * 65], s[5 * 65]); o.w = pk2(s[6 * 65], s[7 * 65]);
        *(u32x4*)(WT + (size_t)tr_dst(mode, cb, n) * 1024 + k0 + 8 * c) = o; }
    asm volatile("s_waitcnt lgkmcnt(0)" ::: "memory");
}
__device__ __forceinline__ void tr_item8(const float* W, int N, unsigned char* WT, int mode, int kb, int cb, LAS float* scr, int lane) {
    const int k0 = kb * 64; const int src = tr_src(mode, cb, lane, N);
#pragma unroll 16
    for (int kk = 0; kk < 64; ++kk) scr[kk * 65 + lane] = __builtin_nontemporal_load(W + (size_t)(k0 + kk) * N + src);
    asm volatile("s_waitcnt lgkmcnt(0)" ::: "memory");
    const int c = lane & 3;
#pragma unroll
    for (int j = 0; j < 4; ++j) { const int n = (lane >> 2) + 16 * j; const LAS float* s = scr + (16 * c) * 65 + n;
        u32x4 o;
        o.x = pk4_fp8(s[0] * W8_SCALE, s[65] * W8_SCALE, s[2 * 65] * W8_SCALE, s[3 * 65] * W8_SCALE); o.y = pk4_fp8(s[4 * 65] * W8_SCALE, s[5 * 65] * W8_SCALE, s[6 * 65] * W8_SCALE, s[7 * 65] * W8_SCALE);
        o.z = pk4_fp8(s[8 * 65] * W8_SCALE, s[9 * 65] * W8_SCALE, s[10 * 65] * W8_SCALE, s[11 * 65] * W8_SCALE); o.w = pk4_fp8(s[12 * 65] * W8_SCALE, s[13 * 65] * W8_SCALE, s[14 * 65] * W8_SCALE, s[15 * 65] * W8_SCALE);
        *(u32x4*)(WT + (size_t)tr_dst(mode, cb, n) * 1024 + k0 + 16 * c) = o; }
    asm volatile("s_waitcnt lgkmcnt(0)" ::: "memory");
}
constexpr int MOE_ITEMS_GU = NE * 16 * 32, MOE_ITEMS = MOE_ITEMS_GU + NE * 16 * 16;
__device__ __forceinline__ void conv_moe_item(const Cx& p, int l, int I, LAS float* scr, int lane) {
    if (I < MOE_ITEMS_GU) { const int e = I >> 9, rr = I & 511, kb = rr >> 5, cb = rr & 31;
        tr_item8(as_global(p.k->in[I_WGU]) + (size_t)(l * NE + e) * 1024 * 2048, 2048, as_global(p.k->ws) + OFF_WGU + (size_t)(l * NE + e) * 2 * MiB, 2, kb, cb, scr, lane); }
    else { const int J = I - MOE_ITEMS_GU, e = J >> 8, rr = J & 255, kb = rr >> 4, cb = rr & 15;
        tr_item8(as_global(p.k->in[I_WD]) + (size_t)(l * NE + e) * 1024 * 1024, 1024, as_global(p.k->ws) + OFF_WD + (size_t)(l * NE + e) * 1 * MiB, 0, kb, cb, scr, lane); }
}
constexpr int TAIL_Q = 3;
__device__ __forceinline__ int tail_cap(int total, int G) { const int rounds = (total + G - 1) / G, rem = total - (rounds - 1) * G; return rem == G ? 0 : (G - rem) * NWV * TAIL_Q; }
__device__ __forceinline__ void tail_convert(const Cx& p, LAS unsigned char* lds, int lnext, int base, int total) {
    const int G = gridDim.x, c = blockIdx.x, rounds = (total + G - 1) / G, rem = total - (rounds - 1) * G;
    if (rem == G || c < rem) return;
    const int tid = opaque_tid(p.wv), lane = tid & 63, wave = p.wv; LAS float* scr = (LAS float*)(lds + wave * 16640);
    const int i0 = base + ((c - rem) * NWV + wave) * TAIL_Q;
#pragma unroll 1
    for (int k = 0; k < TAIL_Q; ++k) if (i0 + k < MOE_ITEMS) conv_moe_item(p, lnext, i0 + k, scr, lane);
}
__device__ __forceinline__ void conv_catchup(const Cx& p, LAS unsigned char* lds, int l, int covered) {
    const int tid = opaque_tid(p.wv), lane = tid & 63, wave = p.wv; LAS float* scr = (LAS float*)(lds + wave * 16640);
    for (int I = covered + blockIdx.x * NWV + wave; I < MOE_ITEMS; I += gridDim.x * NWV) conv_moe_item(p, l, I, scr, lane);
    WG_SYNC();
}
__device__ __forceinline__ void ph_prep(const Cx& p, LAS unsigned char* lds) {
    const int tid = opaque_tid(p.wv), lane = tid & 63, wave = tid >> 6;
    LAS float* scr = (LAS float*)(lds + wave * 16640);
    const int gw = blockIdx.x * NWV + wave, NGW = gridDim.x * NWV;
    constexpr int NJ = 7;
    const int jsrc[NJ] = {I_WGU, I_WD, I_GLUW, I_SCWIN, I_SCWOUT, I_PW1W, I_PW2W};
    const int jN[NJ] = {2048, 1024, 2048, 3072, 1024, 2048, 1024};
    const int jmode[NJ] = {2, 0, 1, 3, 0, 1, 0};
    const int jnmat[NJ] = {128, 128, 2, 1, 1, 1, 1};
    const size_t joff[NJ] = {OFF_WGU, OFF_WD, OFF_WGLU, OFF_WSCIN, OFF_WSCOUT, OFF_WPW1, OFF_WPW2};
    { LAS float* pw = (LAS float*)lds;
      LAS float* ql = pw + 4224; LAS float* cl = pw + 4352; LAS float* bl = pw + 6400;
      for (int item = blockIdx.x; item < 2 * 2 * 64; item += gridDim.x) {
          const int jd = item >> 6, g = item & 63, jj = jd >> 1, d = jd & 1;
          WG_SYNC();
          { const int n = tid & 63, eg = tid >> 6, i = (jd * 64 + g) * 64 + n; const float lre = as_global(p.k->in[I_LRE])[i], lim = as_global(p.k->in[I_LIM])[i], dt = __expf(as_global(p.k->in[I_LDT])[i >> 6]);
#pragma unroll 1
            for (int e = eg; e <= 32; e += 8) { const float er = expf(lre * dt * (float)e), ang = lim * dt * (float)e; pw[(e * 64 + n) * 2] = er * cosf(ang); pw[(e * 64 + n) * 2 + 1] = er * sinf(ang); }
            if (eg == 1) { const float er = expf(lre * dt), nr = er * cosf(lim * dt) - 1.f, ni = er * sinf(lim * dt), den = 1.f / (lre * lre + lim * lim);
                ql[n * 2] = (nr * lre + ni * lim) * den; ql[n * 2 + 1] = (ni * lre - nr * lim) * den; }
            const size_t cb0 = (size_t)(jd * 64 + g) * 1024;
#pragma unroll
            for (int q = 0; q < 2; ++q) { const int idx = tid + NTHR * q; cl[idx * 2] = as_global(p.k->in[I_CRE])[cb0 + idx]; cl[idx * 2 + 1] = as_global(p.k->in[I_CIM])[cb0 + idx];
                bl[idx * 2] = as_global(p.k->in[I_BRE])[cb0 + idx]; bl[idx * 2 + 1] = as_global(p.k->in[I_BIM])[cb0 + idx]; } }
          WG_SYNC();
          { const int pair = tid & 255, hq = pair >> 4, hp = pair & 15, lh = tid >> 8;
            unsigned short* kt = (unsigned short*)(as_global(p.k->ws) + OFF_KT + (size_t)((jj * 64 + g) * 2 + d) * 16896);
            float sacc[16];
#pragma unroll
            for (int q = 0; q < 16; ++q) sacc[q] = 0.f;
            if (lh == 0) kt[pair] = 0;
#pragma unroll 2
            for (int n = 0; n < 64; ++n) { const float qr = ql[n * 2], qi = ql[n * 2 + 1], br = bl[(n * 16 + hp) * 2], bi = bl[(n * 16 + hp) * 2 + 1], cr = cl[(hq * 64 + n) * 2], ci = cl[(hq * 64 + n) * 2 + 1];
                const float bbr = qr * br - qi * bi, bbi = qr * bi + qi * br, cbr = cr * bbr - ci * bbi, cbi = cr * bbi + ci * bbr;
#pragma unroll
                for (int q = 0; q < 16; ++q) { const int lg = 16 * lh + q; sacc[q] += cbr * pw[(lg * 64 + n) * 2] - cbi * pw[(lg * 64 + n) * 2 + 1]; } }
#pragma unroll
            for (int q = 0; q < 16; ++q) kt[(16 * lh + q + 1) * 256 + pair] = (unsigned short)(pk2(sacc[q], 0.f) & 0xffffu); }
          { const int t = tid >> 4, hq = tid & 15, e = d == 0 ? t + 1 : 32 - t, m = t >> 1, ii = (t & 1) * 16 + hq;
            unsigned char* gt = as_global(p.k->ws) + OFF_GT + (size_t)((jj * 64 + g) * 2 + d) * 131072;
#pragma unroll 4
            for (int n = 0; n < 64; ++n) { const float pr = pw[(e * 64 + n) * 2], pi = pw[(e * 64 + n) * 2 + 1], cr = cl[(hq * 64 + n) * 2], ci = cl[(hq * 64 + n) * 2 + 1];
                *(unsigned*)(gt + ((m * 8 + (n >> 3)) * 64 + ((n >> 2) & 1) * 32 + ii) * 16 + (n & 3) * 4) = pk2(cr * pr - ci * pi, -(cr * pi + ci * pr)); } }
          { const int ig = tid & 127, mt = ig >> 5, ii = ig & 31, st = 16 * mt + (ii >> 1), ri = ii & 1, hf = (tid >> 7) & 1, sg = tid >> 8;
            unsigned char* wt = as_global(p.k->ws) + OFF_WT + (size_t)((jj * 64 + g) * 2 + d) * 131072;
            const float qr = ql[st * 2], qi = ql[st * 2 + 1]; float bbr[8], bbi[8];
#pragma unroll
            for (int c = 0; c < 8; ++c) { const float br = bl[(st * 16 + 8 * hf + c) * 2], bi = bl[(st * 16 + 8 * hf + c) * 2 + 1]; bbr[c] = qr * br - qi * bi; bbi[c] = qr * bi + qi * br; }
#pragma unroll 2
            for (int s = 16 * sg; s < 16 * sg + 16; ++s) { const int e = d == 0 ? 31 - s : s; const float pr = pw[(e * 64 + st) * 2], pi = pw[(e * 64 + st) * 2 + 1]; float v[8];
#pragma unroll
                for (int c = 0; c < 8; ++c) v[c] = ri ? pr * bbi[c] + pi * bbr[c] : pr * bbr[c] - pi * bbi[c];
                u32x4 o; o.x = pk2(v[0], v[1]); o.y = pk2(v[2], v[3]); o.z = pk2(v[4], v[5]); o.w = pk2(v[6], v[7]);
                *(u32x4*)(wt + ((mt * 32 + s) * 64 + hf * 32 + ii) * 16) = o; } }
      }
      WG_SYNC(); }
    int base = 0;
#pragma unroll
    for (int j = 2; j < NJ; ++j) {
        const int N = jN[j], ncb = N / 64, ipm = 16 * ncb, tot = ipm * jnmat[j];
        const float* W0 = as_global(p.k->in[jsrc[j]]); bf16_t* T0 = (bf16_t*)(as_global(p.k->ws) + joff[j]);
        int first = gw - (base % NGW); if (first < 0) first += NGW;
        for (int it = first; it < tot; it += NGW) { const int mat = it / ipm, rr = it % ipm, kb = rr / ncb, cb = rr % ncb;
            if (j != 3) tr_item8(W0 + (size_t)mat * 1024 * N, N, (unsigned char*)T0 + (size_t)mat * N * 1024, jmode[j], kb, cb, scr, lane);
            else tr_item(W0 + (size_t)mat * 1024 * N, N, T0 + (size_t)mat * N * 1024, jmode[j], kb, cb, scr, lane); }
        base += tot;
    }
    { int first = gw - (base % NGW); if (first < 0) first += NGW;
      for (int I = first; I < MOE_ITEMS; I += NGW) conv_moe_item(p, 0, I, scr, lane); }
    { f32x4* tb = (f32x4*)(as_global(p.k->ws) + OFF_S5T);
      for (int i = blockIdx.x * NTHR + tid; i < 4 * 64 * 64; i += gridDim.x * NTHR) {
          const float lre = as_global(p.k->in[I_LRE])[i], lim = as_global(p.k->in[I_LIM])[i], dt = __expf(as_global(p.k->in[I_LDT])[i >> 6]);
          const float er = expf(lre * dt), lbr = er * cosf(lim * dt), lbi = er * sinf(lim * dt);
          const float nr = lbr - 1.f, ni = lbi, den = 1.f / (lre * lre + lim * lim);
          tb[i] = (f32x4){lbr, lbi, (nr * lre + ni * lim) * den, (ni * lre - nr * lim) * den}; } }
    { const float* rw = as_global(p.k->in[I_RW]); bf16_t* rt = (bf16_t*)(as_global(p.k->ws) + OFF_RWT);
      for (int i = blockIdx.x * NTHR + tid; i < DEPTH * NE * D; i += gridDim.x * NTHR) { const int k = i & 1023, e = (i >> 10) & 31, l = i >> 15;
          rt[i] = (bf16_t)(pk2(rw[((size_t)l * D + k) * NE + e], 0.f) & 0xffffu); } }
    { const float* bgu = as_global(p.k->in[I_BGU]); float* bp = (float*)(as_global(p.k->ws) + OFF_BGUP);
      for (int i = blockIdx.x * NTHR + tid; i < DEPTH * NE * 2048; i += gridDim.x * NTHR) {
          const int n = i & 2047, m = i >> 11, pn = n >> 8, s = (n >> 7) & 1, jj = n & 127;
          bp[i] = bgu[(size_t)m * 2048 + 2 * (128 * pn + jj) + s]; } }
}
__device__ __forceinline__ void ph_mod(const Cx& p, LAS unsigned char* lds) {
    const int tid = opaque_tid(p.wv), lane = tid & 63, wave = tid >> 6;
    LAS float* sc = (LAS float*)lds; LAS float* red = sc + 5 * 1024;
    for (int i = tid; i < 5 * 1024; i += NTHR) { const int bi = i >> 10, k = i & 1023; const float v = bi < 4 ? as_global(p.k->in[I_C])[bi * 1024 + k] : as_global(p.k->in[I_CCTX])[k]; sc[i] = silu(v); }
    WG_SYNC();
    float* mod = (float*)(as_global(p.k->ws) + OFF_MOD);
    for (int item = blockIdx.x; item < DEPTH * 48; item += gridDim.x) {
        const int l = item / 48, n0 = (item % 48) * 128;
        const float* W = as_global(p.k->in[I_ADAW]) + (size_t)l * 1024 * 6144 + n0 + lane * 2;
        float a[5][2];
#pragma unroll
        for (int b = 0; b < 5; ++b) { a[b][0] = 0.f; a[b][1] = 0.f; }
#pragma unroll 16
        for (int k = wave * 128; k < wave * 128 + 128; ++k) { const f32x2 w = __builtin_nontemporal_load((const f32x2*)(W + (size_t)k * 6144));
#pragma unroll
            for (int b = 0; b < 5; ++b) { const float s = sc[b * 1024 + k]; a[b][0] += s * w.x; a[b][1] += s * w.y; } }
#pragma unroll
        for (int b = 0; b < 5; ++b) { red[(wave * 5 + b) * 128 + lane * 2] = a[b][0]; red[(wave * 5 + b) * 128 + lane * 2 + 1] = a[b][1]; }
        WG_SYNC();
        for (int o = tid; o < 640; o += NTHR) { const int b = o >> 7, col = o & 127; float s = as_global(p.k->in[I_ADAB])[l * 6144 + n0 + col];
#pragma unroll
            for (int w = 0; w < 8; ++w) s += red[(w * 5 + b) * 128 + col];
            mod[(size_t)(l * 5 + b) * 6144 + n0 + col] = s; }
        WG_SYNC();
    }
}
__device__ __forceinline__ void ph_norm_first(const Cx& p) {
    const int tid = opaque_tid(p.wv), lane = tid & 63, wave = tid >> 6;
    bf16_t* X = (bf16_t*)(as_global(p.k->ws) + OFF_X); bf16_t* HN = (bf16_t*)(as_global(p.k->ws) + OFF_HN); const float* mod = (const float*)(as_global(p.k->ws) + OFF_MOD);
    for (int row = blockIdx.x * NWV + wave; row < RTOT; row += gridDim.x * NWV) {
        const float* src = row < RCTX ? as_global(p.k->in[I_CTX]) + (size_t)row * D : as_global(p.k->in[I_X]) + (size_t)(row - RCTX) * D;
        f32x4 v[4], o[4];
#pragma unroll
        for (int j = 0; j < 4; ++j) v[j] = __builtin_nontemporal_load((const f32x4*)(src + 256 * j + 4 * lane));
        store_row_bf16(X + (size_t)row * D, lane, v);
        const float rs = rsqrtf(row_sumsq(v) * (1.f / D) + 1e-6f);
        const float* m = mod + (size_t)(0 * 5 + row_bi(row)) * 6144;
        norm_mod(v, rs, as_global(p.k->in[I_N1G]), m + 1024, m, lane, o);
        store_row_s5(HN, row, lane, o);
    }
}

namespace g8 {
constexpr int BM = 256, BK = 64, HALF = 128, HTB = HALF * BK * 2;
__host__ __device__ __forceinline__ int lds_byte(int r, int c) { const int st = (r >> 4) * 2 + (c >> 5), rr = r & 15, cc = c & 31, ob = rr * 64 + cc * 2; return st * 1024 + (ob ^ (((ob >> 9) & 1) << 5)); }
__host__ __device__ __forceinline__ void stage_rc(int b, int& R, int& C) { const int st = b / 1024, sb = b % 1024, swz = sb ^ (((sb >> 9) & 1) << 5); R = (st >> 1) * 16 + swz / 64; C = (st & 1) * 32 + (swz % 64) / 2; }
__host__ __device__ __forceinline__ int perm32(int rho) { const int n = rho >> 4, i = rho & 15; return 8 * (i >> 2) + 4 * n + (i & 3); }

struct Unit { const char* B; int row0, pn, e, nvalid, lbase, bi, ui, rot; };
constexpr int MOE_TAB_UNITS = 14, MOE_MAX_UNITS = 16;
__device__ __forceinline__ KP fresh(KP k) { asm volatile("" : "+s"(k)); return k; }

template <int RB> struct SchedDenseT {
    KP k; size_t woff; int row_lo, nM, nN, G, c;
    __device__ __forceinline__ bool next(int i, Unit& u) const {
        const int L = i * G + c; if (L >= nM * nN) return false;
        const int pm = L / nN, pn = L % nN;
        u.B = (const char*)(as_global(fresh(k)->ws) + woff) + (size_t)pn * 256 * RB; u.row0 = row_lo + pm * 256; u.pn = pn; u.e = 0; u.nvalid = 256; u.lbase = 0; u.bi = row_bi(u.row0); u.ui = i; u.rot = 0; return true;
    }
    __device__ __forceinline__ unsigned aoff(const Unit& u, int, int r, int C) const { return (unsigned)(u.row0 + r) * (unsigned)RB + (unsigned)C * 2u; }
    static constexpr int ROWB = RB;
};
typedef SchedDenseT<2048> SchedDense;
typedef SchedDenseT<1024> SchedDense8;
struct SchedMoe {
    KP k; size_t woff, estride; const LAS int* desc; const LAS int* tab; int nu; bool gather;
    __device__ __forceinline__ bool next(int i, Unit& u) const {
        if (i >= nu) return false;
        const int e = __builtin_amdgcn_readfirstlane(desc[4 * i]), mg = __builtin_amdgcn_readfirstlane(desc[4 * i + 1]), nv = __builtin_amdgcn_readfirstlane(desc[4 * i + 2]), pr = __builtin_amdgcn_readfirstlane(desc[4 * i + 3]), pn = pr & 0xff;
        u.rot = pr >> 8; u.B = (const char*)(as_global(fresh(k)->ws) + woff) + (size_t)e * estride + (size_t)pn * 256 * ROWB; u.row0 = mg * 256; u.pn = pn; u.e = e; u.nvalid = nv & 0xffff; u.lbase = e * CAP + (nv >> 16) * 256; u.bi = 0; u.ui = i; return true;
    }
    __device__ __forceinline__ unsigned aoff(const Unit& u, int ui, int r, int C) const {
        if (gather) return (unsigned)tab[ui * 256 + r] + (unsigned)C * 2u;
        return (unsigned)(u.row0 + r) * (unsigned)ROWB + (unsigned)C * 2u;
    }
    static constexpr int ROWB = 1024;
};

struct EpiGluRes {
    static constexpr int PERM = 1;
    KP k; int l;
    __device__ __forceinline__ void operator()(const f32x4 (&acc)[2][2][4][2], const Unit& u, int wr, int wc, int fr, int fq) const {
        const KP kk = fresh(k); bf16_t* X = (bf16_t*)(as_global(kk->ws) + OFF_X); const float* bias = as_global(kk->in[I_GLUB]) + (l / 3) * 2048;
        const int j0 = u.pn * 128 + wc * 32 + 8 * fq; const float* g1 = (const float*)(as_global(kk->ws) + OFF_MOD) + (size_t)(l * 5 + u.bi) * 6144 + 2048;
        f32x4 ba[2], bg[2], gg[2];
#pragma unroll
        for (int n = 0; n < 2; ++n) { ba[n] = *(const f32x4*)(bias + j0 + 4 * n); bg[n] = *(const f32x4*)(bias + 1024 + j0 + 4 * n); gg[n] = *(const f32x4*)(g1 + j0 + 4 * n); }
#pragma unroll
        for (int ai = 0; ai < 2; ++ai)
#pragma unroll
            for (int m = 0; m < 4; ++m) { bf16_t* xp = X + (size_t)(u.row0 + ai * 128 + wr * 64 + m * 16 + fr) * D + j0;
                const u32x4 xw = *(const u32x4*)xp; const unsigned xs[4] = {xw.x, xw.y, xw.z, xw.w}; unsigned os[4];
#pragma unroll
                for (int n = 0; n < 2; ++n) { const f32x4 a = acc[ai][0][m][n] * (1.f / W8_SCALE) + ba[n], g = acc[ai][1][m][n] * (1.f / W8_SCALE) + bg[n];
                    f32x4 x = (f32x4){bf2f(xs[2 * n] & 0xffffu), bf2f(xs[2 * n] >> 16), bf2f(xs[2 * n + 1] & 0xffffu), bf2f(xs[2 * n + 1] >> 16)};
                    x.x += gg[n].x * a.x * sigm(g.x); x.y += gg[n].y * a.y * sigm(g.y); x.z += gg[n].z * a.z * sigm(g.z); x.w += gg[n].w * a.w * sigm(g.w);
                    os[2 * n] = pk2(x.x, x.y); os[2 * n + 1] = pk2(x.z, x.w); }
                *(u32x4*)xp = (u32x4){os[0], os[1], os[2], os[3]}; }
    }
};
struct EpiRes {
    static constexpr int PERM = 1;
    KP k; int l, bias_idx;
    __device__ __forceinline__ void operator()(const f32x4 (&acc)[2][2][4][2], const Unit& u, int wr, int wc, int fr, int fq) const {
        const KP kk = fresh(k); bf16_t* X = (bf16_t*)(as_global(kk->ws) + OFF_X); const float* bias = bias_idx >= 0 ? as_global(kk->in[bias_idx]) : nullptr;
        const int c0 = u.pn * 256 + wc * 32 + 8 * fq; const float* g1 = (const float*)(as_global(kk->ws) + OFF_MOD) + (size_t)(l * 5 + u.bi) * 6144 + 2048;
        f32x4 bv[2][2], gg[2][2];
#pragma unroll
        for (int bj = 0; bj < 2; ++bj)
#pragma unroll
            for (int n = 0; n < 2; ++n) { const int c = c0 + 128 * bj + 4 * n; bv[bj][n] = bias ? *(const f32x4*)(bias + c) : (f32x4){0.f, 0.f, 0.f, 0.f}; gg[bj][n] = *(const f32x4*)(g1 + c); }
#pragma unroll
        for (int ai = 0; ai < 2; ++ai)
#pragma unroll
            for (int m = 0; m < 4; ++m) { bf16_t* xp = X + (size_t)(u.row0 + ai * 128 + wr * 64 + m * 16 + fr) * D + c0;
#pragma unroll
                for (int bj = 0; bj < 2; ++bj) { const u32x4 xw = *(const u32x4*)(xp + 128 * bj); const unsigned xs[4] = {xw.x, xw.y, xw.z, xw.w}; unsigned os[4];
#pragma unroll
                    for (int n = 0; n < 2; ++n) { f32x4 x = (f32x4){bf2f(xs[2 * n] & 0xffffu), bf2f(xs[2 * n] >> 16), bf2f(xs[2 * n + 1] & 0xffffu), bf2f(xs[2 * n + 1] >> 16)};
                        x += gg[bj][n] * (acc[ai][bj][m][n] * (1.f / W8_SCALE) + bv[bj][n]); os[2 * n] = pk2(x.x, x.y); os[2 * n + 1] = pk2(x.z, x.w); }
                    *(u32x4*)(xp + 128 * bj) = (u32x4){os[0], os[1], os[2], os[3]}; } }
    }
};
struct EpiBf16 {
    static constexpr int PERM = 1;
    KP k; size_t ooff; int ldc; float dq;
    __device__ __forceinline__ void operator()(const f32x4 (&acc)[2][2][4][2], const Unit& u, int wr, int wc, int fr, int fq) const {
        bf16_t* O = (bf16_t*)(as_global(fresh(k)->ws) + ooff);
        const int c0 = u.pn * 256 + wc * 32 + 8 * fq;
#pragma unroll
        for (int ai = 0; ai < 2; ++ai)
#pragma unroll
            for (int m = 0; m < 4; ++m) { bf16_t* op = O + (size_t)(u.row0 + ai * 128 + wr * 64 + m * 16 + fr) * ldc + c0;
#pragma unroll
                for (int bj = 0; bj < 2; ++bj) { const f32x4 v0 = acc[ai][bj][m][0] * dq, v1 = acc[ai][bj][m][1] * dq;
                    u32x4 w; w.x = pk2(v0.x, v0.y); w.y = pk2(v0.z, v0.w); w.z = pk2(v1.x, v1.y); w.w = pk2(v1.z, v1.w); *(u32x4*)(op + 128 * bj) = w; } }
    }
};
struct EpiScin {
    static constexpr int PERM = 1;
    KP k;
    __device__ __forceinline__ void operator()(const f32x4 (&acc)[2][2][4][2], const Unit& u, int wr, int wc, int fr, int fq) const {
        bf16_t* O = (bf16_t*)(as_global(fresh(k)->ws) + OFF_Z);
        if (u.pn < 8) { const int j0 = u.pn * 128 + wc * 32 + 8 * fq;
#pragma unroll
            for (int ai = 0; ai < 2; ++ai)
#pragma unroll
                for (int m = 0; m < 4; ++m) { const f32x4 p0 = acc[ai][0][m][0] * acc[ai][1][m][0], p1 = acc[ai][0][m][1] * acc[ai][1][m][1];
                    u32x4 w; w.x = pk2(p0.x, p0.y); w.y = pk2(p0.z, p0.w); w.z = pk2(p1.x, p1.y); w.w = pk2(p1.z, p1.w);
                    *(u32x4*)(O + (size_t)(u.row0 + ai * 128 + wr * 64 + m * 16 + fr) * 2048 + j0) = w; }
        } else { const int c0 = 1024 + (u.pn - 8) * 256 + wc * 32 + 8 * fq;
#pragma unroll
            for (int ai = 0; ai < 2; ++ai)
#pragma unroll
                for (int m = 0; m < 4; ++m) { bf16_t* op = O + (size_t)(u.row0 + ai * 128 + wr * 64 + m * 16 + fr) * 2048 + c0;
#pragma unroll
                    for (int bj = 0; bj < 2; ++bj) { const f32x4 v0 = acc[ai][bj][m][0], v1 = acc[ai][bj][m][1];
                        u32x4 w; w.x = pk2(v0.x, v0.y); w.y = pk2(v0.z, v0.w); w.z = pk2(v1.x, v1.y); w.w = pk2(v1.z, v1.w); *(u32x4*)(op + 128 * bj) = w; } }
        }
    }
};
template <int ACT> struct EpiPairBf16 {
    static constexpr int PERM = 1;
    KP k; int l;
    __device__ __forceinline__ void operator()(const f32x4 (&acc)[2][2][4][2], const Unit& u, int wr, int wc, int fr, int fq) const {
        const KP kk = fresh(k);
        unsigned char* Ob = as_global(kk->ws) + (ACT == 0 ? OFF_Z : OFF_HM);
        const float* bb = ACT == 0 ? as_global(kk->in[I_PW1B]) : (const float*)(as_global(kk->ws) + OFF_BGUP) + (size_t)(l * NE + u.e) * 2048;
        const int j0 = u.pn * 128 + wc * 32 + 8 * fq;
        f32x4 ba[2], bg[2];
#pragma unroll
        for (int n = 0; n < 2; ++n) {
            if (ACT == 0) { ba[n] = *(const f32x4*)(bb + j0 + 4 * n); bg[n] = *(const f32x4*)(bb + 1024 + j0 + 4 * n); }
            else { const int q = u.pn * 256 + wc * 32 + 8 * fq + 4 * n; ba[n] = *(const f32x4*)(bb + q); bg[n] = *(const f32x4*)(bb + 128 + q); } }
#pragma unroll
        for (int ai = 0; ai < 2; ++ai)
#pragma unroll
            for (int m = 0; m < 4; ++m) { const size_t orow = (size_t)(u.row0 + ai * 128 + wr * 64 + m * 16 + fr);
                float r[8];
#pragma unroll
                for (int n = 0; n < 2; ++n) { const float dq = 1.f / W8_SCALE; const f32x4 a = acc[ai][0][m][n] * dq + ba[n], g = acc[ai][1][m][n] * dq + bg[n];
#pragma unroll
                    for (int q = 0; q < 4; ++q) {
                        if (ACT == 0) r[4 * n + q] = a[q] * sigm(g[q]);
                        else { const float gt = fminf(a[q], 7.0f), up = fminf(fmaxf(g[q], -7.0f), 7.0f);
                            const float rc = __builtin_amdgcn_rcpf(1.f + __builtin_amdgcn_exp2f(gt * (-1.702f * 1.44269504088896f))); r[4 * n + q] = (gt * rc) * __builtin_fmaf(up, H8_SCALE, H8_SCALE); } } }
                if (ACT == 0) { u32x4 w; w.x = pk2(r[0], r[1]); w.y = pk2(r[2], r[3]); w.z = pk2(r[4], r[5]); w.w = pk2(r[6], r[7]); *(u32x4*)(Ob + orow * 2048 + j0 * 2) = w; }
                else { u32x2 w; w.x = pk4_fp8(r[0], r[1], r[2], r[3]); w.y = pk4_fp8(r[4], r[5], r[6], r[7]); *(u32x2*)(Ob + orow * 1024 + j0) = w; } }
    }
};
struct EpiMoe2 {
    static constexpr int PERM = 2;
    KP k; int l; const LAS int* tflat; const LAS float* tgate;
    __device__ __forceinline__ void operator()(const f32x4 (&acc)[2][2][4][2], const Unit& u, int wr, int wc, int fr, int fq) const {
        const KP kk = fresh(k); unsigned char* Y = as_global(kk->ws) + OFF_Y;
        const int c0 = u.pn * 256 + wc * 64 + 16 * fq; const float* bb = as_global(kk->in[I_BD]) + (size_t)(l * NE + u.e) * D;
        f32x4 bv[2][2];
#pragma unroll
        for (int bj = 0; bj < 2; ++bj)
#pragma unroll
            for (int n = 0; n < 2; ++n) bv[bj][n] = *(const f32x4*)(bb + c0 + 8 * bj + 4 * n);
#pragma unroll
        for (int ai = 0; ai < 2; ++ai)
#pragma unroll
            for (int m = 0; m < 4; ++m) { const int r = ai * 128 + wr * 64 + m * 16 + fr;
                if (r < u.nvalid) { const int flat = tflat[u.ui * 256 + r]; const float gt = tgate[u.ui * 256 + r] * Y8_SCALE; const float dq = 1.f / (W8_SCALE * H8_SCALE);
                    const f32x4 v00 = (acc[ai][0][m][0] * dq + bv[0][0]) * gt, v01 = (acc[ai][0][m][1] * dq + bv[0][1]) * gt, v10 = (acc[ai][1][m][0] * dq + bv[1][0]) * gt, v11 = (acc[ai][1][m][1] * dq + bv[1][1]) * gt;
                    u32x4 w; w.x = pk4_fp8_sat(v00.x, v00.y, v00.z, v00.w); w.y = pk4_fp8_sat(v01.x, v01.y, v01.z, v01.w); w.z = pk4_fp8_sat(v10.x, v10.y, v10.z, v10.w); w.w = pk4_fp8_sat(v11.x, v11.y, v11.z, v11.w);
                    *(u32x4*)(Y + (size_t)flat * D + c0) = w; } }
    }
};

template <bool FP8> __device__ __forceinline__ f32x4 mma_one(const bf16x8& b0, const bf16x8& b1, const bf16x8& a0, const bf16x8& a1, const f32x4& c, int kk) {
    if constexpr (FP8) { const i32x4 bl = __builtin_bit_cast(i32x4, b0), bh = __builtin_bit_cast(i32x4, b1), al = __builtin_bit_cast(i32x4, a0), ah = __builtin_bit_cast(i32x4, a1);
        const i32x8 bv = __builtin_shufflevector(bl, bh, 0, 1, 2, 3, 4, 5, 6, 7), av = __builtin_shufflevector(al, ah, 0, 1, 2, 3, 4, 5, 6, 7);
        return __builtin_amdgcn_mfma_scale_f32_16x16x128_f8f6f4(bv, av, c, 0, 0, 0, 0, 0, 0); }
    else return __builtin_amdgcn_mfma_f32_16x16x32_bf16(kk ? b1 : b0, kk ? a1 : a0, c, 0, 0, 0);
}
template <class Epi, class Sched, bool FP8 = false>
__device__ __forceinline__ void gemm_phase(LAS unsigned char* lds, KP k, size_t a_off, const Sched& S, const Epi& E, int wv) {
    const char* Abase = (const char*)(as_global(fresh(k)->ws) + a_off);
    const int tid = opaque_tid(wv), wid = __builtin_amdgcn_readfirstlane(tid >> 6), lane = tid & 63, wr = wid >> 2, wc = wid & 3, fr = lane & 15, fq = lane >> 4;
    constexpr int ROWB = Sched::ROWB, nt = ROWB / 128, KOFF = 1024;
    static_assert(FP8 == (ROWB == 1024), "operand row pitch");
    int sR[2], sC[2]; unsigned voffB[2];
#pragma unroll
    for (int i = 0; i < 2; ++i) { stage_rc(tid * 16 + i * 8192, sR[i], sC[i]); const int Rb = Epi::PERM == 1 ? ((sR[i] & ~31) + perm32(sR[i] & 31)) : Epi::PERM == 2 ? 64 * (sR[i] >> 5) + 16 * ((sR[i] & 15) >> 2) + 4 * ((sR[i] >> 4) & 1) + (sR[i] & 3) : sR[i]; voffB[i] = (unsigned)(Rb * ROWB + sC[i] * 2); }
    constexpr size_t kstep = 128, hstep = (size_t)(Epi::PERM == 2 ? 8 : HALF) * ROWB;
    const unsigned ldsw = (unsigned)wid * 1024u;
    const int fcol = fq * 8;
    const int aoff = lds_byte(wr * 64 + fr, fcol), boff = lds_byte(wc * 32 + fr, fcol);
#define PG8_SA(b, h) (((b) * 2 + (h)) * HTB)
#define PG8_SB(b, h) ((4 + (b) * 2 + (h)) * HTB)
#define PG8_STAGE(bufoff, gbase, voff) do { _Pragma("unroll") for (int _i = 0; _i < 2; ++_i) \
        __builtin_amdgcn_global_load_lds((const unsigned*)((const char*)(gbase) + (voff)[_i]), (LAS unsigned*)(lds + (bufoff) + ldsw + _i * 8192), 16, 0, 0); } while (0)
#define PG8_LDA(dst, b, h) do { _Pragma("unroll") for (int m = 0; m < 4; ++m) _Pragma("unroll") for (int k = 0; k < 2; ++k) dst[m][k] = *(const LAS bf16x8*)(lds + PG8_SA(b, h) + aoff + m * 2048 + k * KOFF); } while (0)
#define PG8_LDB(dst, b, h) do { _Pragma("unroll") for (int n = 0; n < 2; ++n) _Pragma("unroll") for (int k = 0; k < 2; ++k) dst[n][k] = *(const LAS bf16x8*)(lds + PG8_SB(b, h) + boff + n * 2048 + k * KOFF); } while (0)
#define PG8_MMA(ai, bj, At, Bt) do { __builtin_amdgcn_s_setprio(1); _Pragma("unroll") for (int m = 0; m < 4; ++m) _Pragma("unroll") for (int n = 0; n < 2; ++n) _Pragma("unroll") for (int k = 0; k < (FP8 ? 1 : 2); ++k) \
        acc[ai][bj][m][n] = mma_one<FP8>(Bt[n][0], Bt[n][1], At[m][0], At[m][1], acc[ai][bj][m][n], k); __builtin_amdgcn_s_setprio(0); } while (0)
#define PG8_MMA2(ai, At) do { __builtin_amdgcn_s_setprio(1); _Pragma("unroll") for (int bj_ = 0; bj_ < 2; ++bj_) _Pragma("unroll") for (int m = 0; m < 4; ++m) _Pragma("unroll") for (int n = 0; n < 2; ++n) _Pragma("unroll") for (int k = 0; k < (FP8 ? 1 : 2); ++k) \
        acc[ai][bj_][m][n] = bj_ ? mma_one<FP8>(B1[n][0], B1[n][1], At[m][0], At[m][1], acc[ai][bj_][m][n], k) : mma_one<FP8>(B0[n][0], B0[n][1], At[m][0], At[m][1], acc[ai][bj_][m][n], k); __builtin_amdgcn_s_setprio(0); } while (0)
#define PG8_WAIT_V(n) asm volatile("s_waitcnt vmcnt(" #n ")" ::: "memory")
#define PG8_WAIT_L(n) asm volatile("s_waitcnt lgkmcnt(" #n ")" ::: "memory")
#define PG8_BAR __builtin_amdgcn_s_barrier()
#define PG8_SCHED __builtin_amdgcn_sched_barrier(0)
    Unit cur, nxt; int ui = 0;
    if (!S.next(0, cur)) return;
    f32x4 acc[2][2][4][2];
#pragma unroll
    for (int a = 0; a < 2; ++a)
#pragma unroll
        for (int b = 0; b < 2; ++b)
#pragma unroll
            for (int m = 0; m < 4; ++m)
#pragma unroll
                for (int n = 0; n < 2; ++n) acc[a][b][m][n] = (f32x4){0.f, 0.f, 0.f, 0.f};
    bf16x8 At[4][2], B0[2][2], B1[2][2];
    unsigned voffA[2][2];
#pragma unroll
    for (int h = 0; h < 2; ++h)
#pragma unroll
        for (int i = 0; i < 2; ++i) voffA[h][i] = S.aoff(cur, 0, h * 128 + sR[i], sC[i]);
    const char* cB = cur.B;
#define PG8_KT(j, rot) ((size_t)(((j) + (rot)) & (nt - 1)) * kstep)
    int crot = cur.rot;
    { const size_t k0 = PG8_KT(0, crot), k1 = PG8_KT(1, crot);
    PG8_STAGE(PG8_SB(0, 0), cB + k0, voffB); PG8_STAGE(PG8_SB(0, 1), cB + hstep + k0, voffB); PG8_STAGE(PG8_SA(0, 0), Abase + k0, voffA[0]); PG8_STAGE(PG8_SA(0, 1), Abase + k0, voffA[1]);
    if (wr == 1) PG8_BAR;
    PG8_WAIT_V(2); PG8_BAR;
    PG8_STAGE(PG8_SB(1, 0), cB + k1, voffB); PG8_STAGE(PG8_SA(1, 0), Abase + k1, voffA[0]); PG8_STAGE(PG8_SB(1, 1), cB + hstep + k1, voffB); }
    PG8_WAIT_V(6); PG8_BAR;
    for (;;) {
        const bool has_next = S.next(ui + 1, nxt);
        const char* nB = has_next ? nxt.B : cB; const int nrot = has_next ? nxt.rot : 0;
        for (int t = 0; t < nt; t += 2) {
            const bool last = (t == nt - 2);
            const size_t o1 = PG8_KT(t + 1, crot), o2 = last ? PG8_KT(0, nrot) : PG8_KT(t + 2, crot), o3 = last ? PG8_KT(1, nrot) : PG8_KT(t + 3, crot);
            const char* a1 = Abase + o1;
            const char* a2 = Abase + o2; const char* b2 = (last ? nB : cB) + o2;
            const char* a3 = Abase + o3; const char* b3 = (last ? nB : cB) + o3;
            PG8_LDB(B0, 0, 0); PG8_LDB(B1, 0, 1); PG8_SCHED; PG8_LDA(At, 0, 0); PG8_STAGE(PG8_SA(1, 1), a1, voffA[1]);
            if (last && has_next) {
#pragma unroll
                for (int h = 0; h < 2; ++h)
#pragma unroll
                    for (int i = 0; i < 2; ++i) voffA[h][i] = S.aoff(nxt, ui + 1, h * 128 + sR[i], sC[i]);
            }
            PG8_WAIT_V(8); PG8_WAIT_L(0); PG8_BAR; PG8_MMA2(0, At); PG8_BAR; PG8_SCHED;
            PG8_LDA(At, 0, 1); PG8_STAGE(PG8_SB(0, 0), b2, voffB); PG8_STAGE(PG8_SB(0, 1), b2 + hstep, voffB); PG8_STAGE(PG8_SA(0, 0), a2, voffA[0]);
            PG8_WAIT_V(8); PG8_WAIT_L(0); PG8_BAR; PG8_MMA2(1, At); PG8_BAR; PG8_SCHED;
            PG8_LDB(B0, 1, 0); PG8_LDB(B1, 1, 1); PG8_SCHED; PG8_LDA(At, 1, 0); PG8_STAGE(PG8_SA(0, 1), a2, voffA[1]);
            PG8_WAIT_V(8); PG8_WAIT_L(0); PG8_BAR; PG8_MMA2(0, At); PG8_BAR; PG8_SCHED;
            PG8_LDA(At, 1, 1); PG8_STAGE(PG8_SB(1, 0), b3, voffB); PG8_STAGE(PG8_SB(1, 1), b3 + hstep, voffB); PG8_STAGE(PG8_SA(1, 0), a3, voffA[0]);
            PG8_WAIT_V(8); PG8_WAIT_L(0); PG8_BAR; PG8_MMA2(1, At); PG8_BAR; PG8_SCHED;
        }
        if (wr == 0) PG8_BAR;
        E(acc, cur, wr, wc, fr, fq);
        if (!has_next) break;
#pragma unroll
        for (int a = 0; a < 2; ++a)
#pragma unroll
            for (int b = 0; b < 2; ++b)
#pragma unroll
                for (int m = 0; m < 4; ++m)
#pragma unroll
                    for (int n = 0; n < 2; ++n) acc[a][b][m][n] = (f32x4){0.f, 0.f, 0.f, 0.f};
        cur = nxt; cB = nB; crot = nrot; ++ui;
        if (wr == 1) PG8_BAR;
    }
    PG8_WAIT_V(0);
    PG8_BAR;
#undef PG8_KT
#undef PG8_SA
#undef PG8_SB
#undef PG8_STAGE
#undef PG8_LDA
#undef PG8_LDB
#undef PG8_MMA
#undef PG8_MMA2
#undef PG8_WAIT_V
#undef PG8_WAIT_L
#undef PG8_BAR
#undef PG8_SCHED
}
}

typedef float f32x16 __attribute__((ext_vector_type(16)));
__device__ __forceinline__ void s5_lam(const Cx& p, int jd, int g, int pp, float& lbr, float& lbi, float& qr, float& qi) {
    const f32x4 t = *(const f32x4*)(as_global(p.k->ws) + OFF_S5T + (size_t)((jd * 64 + g) * 64 + pp) * 16); lbr = t.x; lbi = t.y; qr = t.z; qi = t.w;
}
__device__ __forceinline__ int s5_tbi(int d, int B, int st) { return (d * 136 + B) * 64 + (st ^ ((B & 15) << 2)); }
__device__ __forceinline__ int s5_row(int b, int B, int t) { return B < 8 ? b * NCTX + 32 * B + t : RCTX + b * SEQ + 32 * (B - 8) + t; }
__device__ __forceinline__ void ph_s5(const Cx& p, int l, LAS unsigned char* lds) {
    const int tid = opaque_tid(p.wv), lane = tid & 63, wave = p.wv, n = lane & 31, h = lane >> 5, j = l / 3; const bool last = (l == DEPTH - 1);
    const bf16_t* HN = (const bf16_t*)(as_global(p.k->ws) + OFF_HN); bf16_t* A2 = (bf16_t*)(as_global(p.k->ws) + OFF_A2);
    LAS unsigned* Tb = (LAS unsigned*)lds;
    for (int wg = blockIdx.x; wg < NBATCH * 64; wg += gridDim.x) {
        const int tid = opaque_tid(p.wv), lane = tid & 63, n = lane & 31, h = lane >> 5;
        const int b = wg >> 6, g = wg & 63;
        const bf16_t* HNs = HN + (size_t)(b * 64 + g) * (NCTX + SEQ) * 16;
        float lbr[2], lbi[2];
#pragma unroll
        for (int d = 0; d < 2; ++d) { const int jd = j * 2 + d; float qr, qi; s5_lam(p, jd, g, lane, lbr[d], lbi[d], qr, qi); }
        WG_SYNC();
        {
            LAS unsigned char* Ub = lds + 69632;
            const int d = wave >> 2, mt = wave & 3;
            const unsigned char* WTg = as_global(p.k->ws) + OFF_WT + (size_t)((j * 64 + g) * 2 + d) * 131072;
            bf16x8 wf[32];
#pragma unroll
            for (int s = 0; s < 32; ++s) wf[s] = *(const bf16x8*)(WTg + ((mt * 32 + s) * 64 + lane) * 16);
            u32x4 uv[4];
#pragma unroll
            for (int q = 0; q < 4; ++q) { const int pc = tid + NTHR * q; uv[q] = *(const u32x4*)(HNs + (size_t)(pc >> 1) * 16 + 8 * (pc & 1)); }
#pragma unroll 1
            for (int nt = 0; nt < 5; ++nt) {
                WG_SYNC();
#pragma unroll
                for (int q = 0; q < 4; ++q) { const int pc = tid + NTHR * q, tk = pc >> 1, hf = pc & 1, nn = tk >> 5, s = tk & 31;
                    *(LAS u32x4*)(Ub + s * 1024 + ((nn ^ s) & 31) * 32 + hf * 16) = uv[q]; }
                WG_SYNC();
                if (nt < 4) {
#pragma unroll
                    for (int q = 0; q < 4; ++q) { const int pc = tid + NTHR * q, tok = 1024 * (nt + 1) + (pc >> 1);
                        uv[q] = (u32x4){0u, 0u, 0u, 0u}; if (tok < NCTX + SEQ) uv[q] = *(const u32x4*)(HNs + (size_t)tok * 16 + 8 * (pc & 1)); } }
                f32x16 e0, e1;
#pragma unroll
                for (int q = 0; q < 16; ++q) { e0[q] = 0.f; e1[q] = 0.f; }
#pragma unroll
                for (int s = 0; s < 32; s += 2) {
                    e0 = __builtin_amdgcn_mfma_f32_32x32x16_bf16(wf[s], *(const LAS bf16x8*)(Ub + s * 1024 + ((n ^ s) & 31) * 32 + h * 16), e0, 0, 0, 0);
                    e1 = __builtin_amdgcn_mfma_f32_32x32x16_bf16(wf[s + 1], *(const LAS bf16x8*)(Ub + (s + 1) * 1024 + ((n ^ (s + 1)) & 31) * 32 + h * 16), e1, 0, 0, 0); }
                const int B = 32 * nt + n;
                if (B < 136) {
#pragma unroll
                    for (int q = 0; q < 4; ++q) { u32x2 o; o.x = pk2(e0[4 * q] + e1[4 * q], e0[4 * q + 1] + e1[4 * q + 1]); o.y = pk2(e0[4 * q + 2] + e1[4 * q + 2], e0[4 * q + 3] + e1[4 * q + 3]);
                        *(LAS u32x2*)(Tb + (d * 136 + B) * 64 + 16 * mt + 4 * q + 2 * h) = o; } }
            }
        }
        WG_SYNC();
        if (wave < 2) { const int d = wave; float ar = lbr[d], ai = lbi[d];
#pragma unroll
            for (int q = 0; q < 5; ++q) { const float t2 = ar * ar - ai * ai; ai = 2.f * ar * ai; ar = t2; }
            float hr = 0.f, hi = 0.f;
#pragma unroll 1
            for (int i0 = 0; i0 < 136; i0 += 8) {
                unsigned e[8], o[8];
#pragma unroll
                for (int q = 0; q < 8; ++q) { const int i = i0 + q, B = d == 0 ? i : (i < 8 ? 7 - i : 143 - i); e[q] = Tb[(d * 136 + B) * 64 + lane]; }
#pragma unroll
                for (int q = 0; q < 8; ++q) { o[q] = pk2(hr, hi);
                    const float er = __uint_as_float(e[q] << 16), ei = __uint_as_float(e[q] & 0xffff0000u);
                    const float nr = ar * hr - ai * hi + er, ni = ar * hi + ai * hr + ei; hr = nr; hi = ni; }
#pragma unroll
                for (int q = 0; q < 8; ++q) { const int i = i0 + q, B = d == 0 ? i : (i < 8 ? 7 - i : 143 - i); Tb[(d * 136 + B) * 64 + lane] = o[q]; }
            }
        }
        WG_SYNC();
        {
            const int tid = opaque_tid(p.wv), lane = tid & 63, n = lane & 31, h = lane >> 5;
            for (int idx = tid; idx < 272 * 16; idx += NTHR) { const int row = idx >> 4, c = idx & 15, x = (row >= 136 ? row - 136 : row) & 15, c2 = c ^ x;
                if (c < c2) { LAS u32x4* pa = (LAS u32x4*)(Tb + row * 64 + c * 4); LAS u32x4* pb = (LAS u32x4*)(Tb + row * 64 + c2 * 4); const u32x4 va = *pa, vb = *pb; *pa = vb; *pb = va; } }
            LAS unsigned char* Ub = lds + 69632;
            LAS unsigned char* KTl = lds + 102400;
            { const unsigned char* KTg = as_global(p.k->ws) + OFF_KT + (size_t)(j * 64 + g) * 33792;
              for (int pc = tid; pc < 2112; pc += NTHR) *(LAS u32x4*)(KTl + pc * 16) = *(const u32x4*)(KTg + pc * 16); }
            const unsigned char* GTg = as_global(p.k->ws) + OFF_GT + (size_t)(j * 64 + g) * 262144;
            const int m0 = wave, m1 = 15 - wave, toff = n >> 4, hh = n & 15;
            bf16x8 gf[2][2][8];
#pragma unroll
            for (int d = 0; d < 2; ++d)
#pragma unroll
                for (int mi = 0; mi < 2; ++mi)
#pragma unroll
                    for (int ks = 0; ks < 8; ++ks) gf[d][mi][ks] = *(const bf16x8*)(GTg + d * 131072 + (((mi ? m1 : m0) * 8 + ks) * 64 + lane) * 16);
            const float* dd = as_global(p.k->in[I_S5D]) + j * D + 16 * g; const f32x4 dv0 = *(const f32x4*)(dd + 4 * h), dv1 = *(const f32x4*)(dd + 8 + 4 * h);
            const int offF = ((toff + 1) * 16 + hh) * 32 + h * 16, offR = ((34 - toff) * 16 + hh) * 32 + h * 16;
            unsigned char* A2b = (unsigned char*)A2;
            u32x4 uv[4];
#pragma unroll
            for (int q = 0; q < 4; ++q) { const int pc = tid + NTHR * q; uv[q] = *(const u32x4*)(HNs + (size_t)(pc >> 1) * 16 + 8 * (pc & 1)); }
#pragma unroll 1
            for (int nt = 0; nt < 5; ++nt) {
                WG_SYNC();
#pragma unroll
                for (int q = 0; q < 4; ++q) { const int pc = tid + NTHR * q, tk = pc >> 1, hf = pc & 1, nn = tk >> 5, s = tk & 31;
                    *(LAS u32x4*)(Ub + s * 1024 + ((nn ^ s) & 31) * 32 + hf * 16) = uv[q]; }
                WG_SYNC();
                f32x16 aF0, aF1;
#pragma unroll
                for (int q = 0; q < 16; ++q) { aF0[q] = 0.f; aF1[q] = 0.f; }
#pragma unroll 4
                for (int s = 0; s < 32; ++s) {
                    const bf16x8 bu = *(const LAS bf16x8*)(Ub + s * 1024 + ((n ^ s) & 31) * 32 + h * 16);
                    const int o0 = s <= 2 * m0 + 1 ? offF + (2 * m0 - s) * 512 : offR + (s - 2 * m0) * 512, o1 = s <= 2 * m1 + 1 ? offF + (2 * m1 - s) * 512 : offR + (s - 2 * m1) * 512;
                    aF0 = __builtin_amdgcn_mfma_f32_32x32x16_bf16(*(const LAS bf16x8*)(KTl + o0), bu, aF0, 0, 0, 0); aF1 = __builtin_amdgcn_mfma_f32_32x32x16_bf16(*(const LAS bf16x8*)(KTl + o1), bu, aF1, 0, 0, 0);
                }
#pragma unroll
                for (int e = 0; e < 2; ++e) { const int s0 = 2 * m0 + e, s1 = 2 * m1 + e;
                    const bf16x8 b0 = *(const LAS bf16x8*)(Ub + s0 * 1024 + ((n ^ s0) & 31) * 32 + h * 16), b1 = *(const LAS bf16x8*)(Ub + s1 * 1024 + ((n ^ s1) & 31) * 32 + h * 16);
                    const bf16x8 ar = *(const LAS bf16x8*)(KTl + offR + e * 512);
                    aF0 = __builtin_amdgcn_mfma_f32_32x32x16_bf16(ar, b0, aF0, 0, 0, 0); aF1 = __builtin_amdgcn_mfma_f32_32x32x16_bf16(ar, b1, aF1, 0, 0, 0); }
                const int Bc = min(32 * nt + n, 135);
#pragma unroll
                for (int ks = 0; ks < 8; ++ks) {
                    const bf16x8 h0 = *(const LAS bf16x8*)(Tb + s5_tbi(0, Bc, 8 * ks + 4 * h)), h1 = *(const LAS bf16x8*)(Tb + s5_tbi(1, Bc, 8 * ks + 4 * h));
                    aF0 = __builtin_amdgcn_mfma_f32_32x32x16_bf16(gf[0][0][ks], h0, aF0, 0, 0, 0); aF1 = __builtin_amdgcn_mfma_f32_32x32x16_bf16(gf[0][1][ks], h0, aF1, 0, 0, 0);
                    aF0 = __builtin_amdgcn_mfma_f32_32x32x16_bf16(gf[1][0][ks], h1, aF0, 0, 0, 0); aF1 = __builtin_amdgcn_mfma_f32_32x32x16_bf16(gf[1][1][ks], h1, aF1, 0, 0, 0);
                    if (ks & 1) __builtin_amdgcn_sched_barrier(0);
                }
                if (nt < 4) {
#pragma unroll
                    for (int q = 0; q < 4; ++q) { const int pc = tid + NTHR * q, tok = 1024 * (nt + 1) + (pc >> 1);
                        uv[q] = (u32x4){0u, 0u, 0u, 0u}; if (tok < NCTX + SEQ) uv[q] = *(const u32x4*)(HNs + (size_t)tok * 16 + 8 * (pc & 1)); } }
                {   LAS unsigned char* scr = lds + 140288 + wave * 2048;
#pragma unroll
                    for (int mi = 0; mi < 2; ++mi) { const int m = mi ? m1 : m0; const f32x16 y = mi ? aF1 : aF0;
#pragma unroll
                        for (int q4 = 0; q4 < 4; ++q4) { const int t = 2 * m + (q4 >> 1), c0 = 8 * (q4 & 1) + 4 * h;
                            const u32x2 uw = *(const LAS u32x2*)(Ub + t * 1024 + ((n ^ t) & 31) * 32 + c0 * 2); const f32x4 d4 = (q4 & 1) ? dv1 : dv0;
                            *(LAS unsigned*)(scr + ((mi * 2 + (q4 >> 1)) * 32 + n) * 16 + c0) = pk4_fp8_sat(gelu_tanh(y[4 * q4] + d4.x * bf2f(uw.x & 0xffffu)), gelu_tanh(y[4 * q4 + 1] + d4.y * bf2f(uw.x >> 16)),
                                                                                                              gelu_tanh(y[4 * q4 + 2] + d4.z * bf2f(uw.y & 0xffffu)), gelu_tanh(y[4 * q4 + 3] + d4.w * bf2f(uw.y >> 16))); } }
                    asm volatile("s_waitcnt lgkmcnt(0)" ::: "memory");
#pragma unroll
                    for (int k2 = 0; k2 < 2; ++k2) { const int sl = lane + 64 * k2, ti = sl >> 5, B = 32 * nt + (sl & 31), t = 2 * ((ti >> 1) ? m1 : m0) + (ti & 1);
                        const u32x4 o = *(const LAS u32x4*)(scr + sl * 16);
                        if (B < 136 && !(last && B < 8)) *(u32x4*)(A2b + (size_t)s5_row(b, B, t) * D + 16 * g) = o; }
                    asm volatile("s_waitcnt lgkmcnt(0)" ::: "memory");
                }
            }
        }
    }
}
__device__ __forceinline__ void ph_conv3(const Cx& p) {
    const bf16_t* Z = (const bf16_t*)(as_global(p.k->ws) + OFF_Z); bf16_t* A2 = (bf16_t*)(as_global(p.k->ws) + OFF_A2); const float* cw = as_global(p.k->in[I_SCCW]);
    const int tid = opaque_tid(p.wv);
    for (size_t i = (size_t)blockIdx.x * NTHR + tid; i < (size_t)RTOT * D / 4; i += (size_t)gridDim.x * NTHR) {
        const int row = (int)(i >> 8), col = (int)(i & 255) * 4;
        int pos, len; if (row < RCTX) { pos = row & 255; len = 256; } else { pos = (row - RCTX) & 63; len = 64; }
        f32x4 acc = (f32x4){0.f, 0.f, 0.f, 0.f};
#pragma unroll
        for (int d = 0; d < 3; ++d) { const int q = pos + d - 1; const bool ok = (q >= 0 && q < len);
            const bf16_t* zr = Z + (size_t)(ok ? row + d - 1 : row) * 2048; const f32x4 uu = ld_bf16x4(zr + col); f32x4 w = *(const f32x4*)(cw + d * D + col);
            if (!ok) w = (f32x4){0.f, 0.f, 0.f, 0.f};
            acc += w * uu; }
        const u32x2 gw = __builtin_nontemporal_load((const u32x2*)(Z + (size_t)row * 2048 + 1024 + col)); const f32x4 gb = (f32x4){bf2f(gw.x & 0xffffu), bf2f(gw.x >> 16), bf2f(gw.y & 0xffffu), bf2f(gw.y >> 16)}, o = gb * acc;
        *(unsigned*)((unsigned char*)A2 + (size_t)row * D + col) = pk4_fp8_sat(o.x, o.y, o.z, o.w);
    }
}
__device__ __forceinline__ void cf_ln_silu_store(const Cx& p, f32x4 (&a)[4], unsigned char* dst, int lane) {
    float s = 0.f;
#pragma unroll
    for (int j = 0; j < 4; ++j) s += (a[j].x + a[j].y) + (a[j].z + a[j].w);
    const float mu = wave_sum(s) * (1.f / D); float q2 = 0.f;
#pragma unroll
    for (int j = 0; j < 4; ++j) { a[j] = a[j] - mu; q2 += (a[j].x * a[j].x + a[j].y * a[j].y) + (a[j].z * a[j].z + a[j].w * a[j].w); }
    const float rstd = rsqrtf(wave_sum(q2) * (1.f / D) + 1e-5f);
    f32x4 o[4];
#pragma unroll
    for (int j = 0; j < 4; ++j) { const int col = 256 * j + 4 * lane; const f32x4 y = a[j] * rstd * *(const f32x4*)(as_global(p.k->in[I_LNG]) + col) + *(const f32x4*)(as_global(p.k->in[I_LNB]) + col);
        o[j] = (f32x4){silu(y.x), silu(y.y), silu(y.z), silu(y.w)}; }
    store_row_fp8(dst, lane, o);
}
__device__ __forceinline__ void ph_conv31(const Cx& p, LAS unsigned char* lds) {
    const int tid = opaque_tid(p.wv), lane = tid & 63, wave = p.wv;
    const bf16_t* U = (const bf16_t*)(as_global(p.k->ws) + OFF_Z); unsigned char* A2 = as_global(p.k->ws) + OFF_A2; bf16_t* T2 = (bf16_t*)(as_global(p.k->ws) + OFF_HN);
    const float* dw = as_global(p.k->in[I_DWW]);
    for (int item = blockIdx.x; item < NBATCH * 64; item += gridDim.x) {
        const int base = RCTX + (item >> 6) * SEQ + (item & 63);
        WG_SYNC();
#pragma unroll 4
        for (int q = 0; q < 16; ++q) { const int ch = tid + NTHR * q, r = ch >> 7, o16 = ch & 127;
            *(LAS u32x4*)(lds + r * 2048 + o16 * 16) = __builtin_nontemporal_load((const u32x4*)(U + (size_t)(base + 64 * r) * D + o16 * 8)); }
        WG_SYNC();
#pragma unroll 1
        for (int pass = 0; pass < 2; ++pass) {
            const int c0 = 128 * wave + 64 * pass + lane; const LAS unsigned char* col = lds + c0 * 2;
            float w0[31];
#pragma unroll
            for (int d = 0; d < 31; ++d) w0[d] = dw[d * D + c0];
            const float bb = as_global(p.k->in[I_DWB])[c0];
#pragma unroll 1
            for (int blk = 0; blk < 8; ++blk) {
                float in[38];
#pragma unroll
                for (int j = 0; j < 38; ++j) { const int rr = 8 * blk - 15 + j; const int rc = rr < 0 ? 0 : (rr > 63 ? 63 : rr);
                    const float v = __uint_as_float((unsigned)*(const LAS unsigned short*)(col + rc * 2048) << 16); in[j] = (rr >= 0 && rr < 64) ? v : 0.f; }
#pragma unroll
                for (int q = 0; q < 8; ++q) { float a0 = bb;
#pragma unroll
                    for (int d = 0; d < 31; ++d) a0 = fmaf(w0[d], in[q + d], a0);
                    *(unsigned short*)(T2 + (size_t)(base + 64 * (8 * blk + q)) * D + c0) = (unsigned short)(pk2(a0, 0.f) & 0xffffu); }
            }
        }
        asm volatile("s_waitcnt vmcnt(0)" ::: "memory");
        WG_SYNC();
        for (int r = wave; r < 64; r += NWV) { f32x4 a[4]; const bf16_t* pr = T2 + (size_t)(base + 64 * r) * D;
#pragma unroll
            for (int j = 0; j < 4; ++j) a[j] = ld_bf16x4(pr + 256 * j + 4 * lane);
            cf_ln_silu_store(p, a, A2 + (size_t)(base + 64 * r) * D, lane); }
    }
    for (int row = blockIdx.x * NWV + wave; row < RCTX; row += gridDim.x * NWV) {
        const int pos = row & 255, base = row - pos;
        f32x4 a[4];
#pragma unroll
        for (int j = 0; j < 4; ++j) a[j] = *(const f32x4*)(as_global(p.k->in[I_DWB]) + 256 * j + 4 * lane);
        for (int d = 0; d < 31; ++d) { const int q = pos + d - 15;
            if (q >= 0 && q < 256) { const bf16_t* ur = U + (size_t)(base + q) * D;
#pragma unroll
                for (int j = 0; j < 4; ++j) { const int col = 256 * j + 4 * lane; a[j] += *(const f32x4*)(dw + d * D + col) * ld_bf16x4(ur + col); } } }
        cf_ln_silu_store(p, a, A2 + (size_t)row * D, lane);
    }
}
__device__ __forceinline__ void ph_route(const Cx& p, int l, LAS unsigned char* lds) {
    const int tid = opaque_tid(p.wv), lane = tid & 63, wave = p.wv, n = lane & 31, h = lane >> 5;
    const bf16_t* X = (const bf16_t*)(as_global(p.k->ws) + OFF_X); bf16_t* F = (bf16_t*)(as_global(p.k->ws) + OFF_F); const float* mod = (const float*)(as_global(p.k->ws) + OFF_MOD);
    float* gate = (float*)(as_global(p.k->ws) + OFF_GATE); int* elist = (int*)(as_global(p.k->ws) + OFF_ELIST); unsigned* cnt = (unsigned*)(as_global(p.k->ws) + OFF_CTL) + CW_CNT + l * 32;
    const float* rb = as_global(p.k->in[I_RB]) + l * NE;
    constexpr int TS = 2064;
    LAS unsigned char* tile = lds;
    LAS float* part = (LAS float*)(lds + 32 * TS);
    LAS int* lcnt = (LAS int*)(lds + 32 * TS + 32768);
    LAS int* choice = lcnt + 64;
    const int row_lo = (l == DEPTH - 1) ? RCTX : 0, nrows = RTOT - row_lo, G = gridDim.x;
    const int per = (nrows + G - 1) / G, r0 = row_lo + blockIdx.x * per, r1 = min(r0 + per, RTOT);
    bf16x8 Bw[8];
    { const bf16_t* rt = (const bf16_t*)(as_global(p.k->ws) + OFF_RWT) + ((size_t)l * NE + n) * D + 128 * wave + 8 * h;
#pragma unroll
      for (int s = 0; s < 8; ++s) Bw[s] = *(const bf16x8*)(rt + 16 * s); }
    if (tid < 32) lcnt[tid] = 0;
    WG_SYNC();
    for (int rb0 = r0; rb0 < r1; rb0 += 32) {
        const int nb = min(32, r1 - rb0);
        for (int q = wave; q < 32; q += NWV) {
            if (q < nb) { const int row = rb0 + q; f32x4 v[4], f[4]; load_row_bf16(X + (size_t)row * D, lane, v);
                const float rs = rsqrtf(row_sumsq(v) * (1.f / D) + 1e-6f);
                const float* m = mod + (size_t)(l * 5 + row_bi(row)) * 6144;
                norm_mod(v, rs, as_global(p.k->in[I_N2G]) + l * D, m + 4096, m + 3072, lane, f);
#pragma unroll
                for (int j = 0; j < 4; ++j) { u32x2 w; w.x = pk2(f[j].x, f[j].y); w.y = pk2(f[j].z, f[j].w);
                    *(unsigned*)((unsigned char*)F + (size_t)row * D + 256 * j + 4 * lane) = pk4_fp8_sat(f[j].x, f[j].y, f[j].z, f[j].w); *(LAS u32x2*)(tile + q * TS + (256 * j + 4 * lane) * 2) = w; }
            } else {
#pragma unroll
                for (int j = 0; j < 4; ++j) *(LAS u32x2*)(tile + q * TS + (256 * j + 4 * lane) * 2) = (u32x2){0u, 0u};
            }
        }
        WG_SYNC();
        { f32x16 acc;
#pragma unroll
          for (int i = 0; i < 16; ++i) acc[i] = 0.f;
#pragma unroll
          for (int s = 0; s < 8; ++s) { const bf16x8 af = *(const LAS bf16x8*)(tile + n * TS + (128 * wave + 16 * s + 8 * h) * 2); acc = __builtin_amdgcn_mfma_f32_32x32x16_bf16(af, Bw[s], acc, 0, 0, 0); }
#pragma unroll
          for (int r = 0; r < 16; ++r) { const int t = (r & 3) + 8 * (r >> 2) + 4 * h; part[(wave * 32 + t) * 32 + n] = acc[r]; } }
        WG_SYNC();
        {
            const int rr = tid >> 4, sub = tid & 15;
            f32x2 s2 = *(const f32x2*)(rb + 2 * sub);
#pragma unroll
            for (int w = 0; w < 8; ++w) s2 += *(const LAS f32x2*)(part + (w * 32 + rr) * 32 + 2 * sub);
            float v0 = s2.x, v1 = s2.y, bv[4]; int bx[4];
#pragma unroll
            for (int k = 0; k < 4; ++k) { float cv = v1 > v0 ? v1 : v0; int ci = v1 > v0 ? 2 * sub + 1 : 2 * sub;
#pragma unroll
                for (int off = 1; off < 16; off <<= 1) { const float ov = __shfl_xor(cv, off); const int oi = __shfl_xor(ci, off); const bool better = ov > cv || (ov == cv && oi < ci); cv = better ? ov : cv; ci = better ? oi : ci; }
                bv[k] = cv; bx[k] = ci; if (ci == 2 * sub) v0 = -3.0e38f; if (ci == 2 * sub + 1) v1 = -3.0e38f; }
            if (sub == 0 && rr < nb) { const int row = rb0 + rr;
                const float e1 = __expf(bv[1] - bv[0]), e2 = __expf(bv[2] - bv[0]), e3 = __expf(bv[3] - bv[0]), inv = 1.f / (1.f + e1 + e2 + e3);
                *(f32x4*)(gate + (size_t)row * 4) = (f32x4){inv, e1 * inv, e2 * inv, e3 * inv};
#pragma unroll
                for (int k = 0; k < 4; ++k) { const int rank = __hip_atomic_fetch_add(lcnt + bx[k], 1, __ATOMIC_RELAXED, __HIP_MEMORY_SCOPE_WORKGROUP); choice[(row - r0) * 4 + k] = bx[k] | (rank << 8); } }
        }
        WG_SYNC();
    }
    if (tid < 32) { const int c = lcnt[tid]; lcnt[32 + tid] = c ? (int)atomicAdd(&cnt[tid], (unsigned)c) : 0; }
    WG_SYNC();
    for (int i = tid; i < (r1 - r0) * 4; i += NTHR) { const int c = choice[i], e = c & 0xff, rank = c >> 8; elist[e * CAP + lcnt[32 + e] + rank] = (r0 + (i >> 2)) * 4 + (i & 3); }
}
__device__ __forceinline__ void ph_combine(const Cx& p, int l) {
    const int tid = opaque_tid(p.wv), lane = tid & 63, wave = tid >> 6; const bool last = (l == DEPTH - 1);
    bf16_t* X = (bf16_t*)(as_global(p.k->ws) + OFF_X); bf16_t* HN = (bf16_t*)(as_global(p.k->ws) + OFF_HN); const bf16_t* Y = (const bf16_t*)(as_global(p.k->ws) + OFF_Y); const float* mod = (const float*)(as_global(p.k->ws) + OFF_MOD);
    const int row_lo = last ? RCTX : 0;
    for (int row = row_lo + blockIdx.x * NWV + wave; row < RTOT; row += gridDim.x * NWV) {
        f32x4 v[4], o[4]; load_row_bf16(X + (size_t)row * D, lane, v);
        const float* m = mod + (size_t)(l * 5 + row_bi(row)) * 6144;
#pragma unroll
        for (int j = 0; j < 4; ++j) { const int col = 256 * j + 4 * lane; const unsigned char* y = (const unsigned char*)Y + (size_t)row * 4 * D + col;
            f32x4 s = (f32x4){0.f, 0.f, 0.f, 0.f};
#pragma unroll
            for (int q = 0; q < 4; ++q) { const int w = __builtin_nontemporal_load((const int*)(y + q * D)); const f32x2 lo = __builtin_amdgcn_cvt_pk_f32_fp8(w, false), hi = __builtin_amdgcn_cvt_pk_f32_fp8(w, true); s += (f32x4){lo.x, lo.y, hi.x, hi.y}; }
            v[j] += *(const f32x4*)(m + 5120 + col) * (s * (1.f / Y8_SCALE)); }
        const float rs = rsqrtf(row_sumsq(v) * (1.f / D) + 1e-6f);
        if (last) {
            float* op = as_global(p.k->out) + (size_t)(row - RCTX) * D;
#pragma unroll
            for (int j = 0; j < 4; ++j) { const int col = 256 * j + 4 * lane; *(f32x4*)(op + col) = v[j] * rs * *(const f32x4*)(as_global(p.k->in[I_FING]) + col); }
        } else {
            store_row_bf16(X + (size_t)row * D, lane, v);
            const float* m2 = mod + (size_t)((l + 1) * 5 + row_bi(row)) * 6144;
            norm_mod(v, rs, as_global(p.k->in[I_N1G]) + (l + 1) * D, m2 + 1024, m2, lane, o);
            if ((l + 1) % 3 == 0) store_row_s5(HN, row, lane, o); else if ((l + 1) % 3 == 2) store_row_fp8((unsigned char*)HN + (size_t)row * D, lane, o);
            else store_row_bf16(HN + (size_t)row * D, lane, o);
        }
    }
}

__device__ __forceinline__ int moe_setup(const Cx& p, int l, LAS unsigned char* lds, int NTl, bool gather) {
    LAS int* pt = (LAS int*)(lds + LDS_MISC); LAS int* desc = (LAS int*)(lds + LDS_MISC + 512); LAS int* tab = (LAS int*)(lds + LDS_MISC + 1024);
    const int tid = opaque_tid(p.wv), G = gridDim.x, c = blockIdx.x;
    const int* cnt = (const int*)(as_global(p.k->ws) + OFF_CTL) + CW_CNT + l * 32; const int* elist = (const int*)(as_global(p.k->ws) + OFF_ELIST);
    WG_SYNC();
    if (tid == 0) { int s = 0; for (int e = 0; e < 32; ++e) { pt[e] = s; s += (cnt[e] + 255) >> 8; } pt[32] = s; }
    WG_SYNC();
    const int TMt = pt[32], S8 = G >> 3, x8 = c & 7, s8 = c >> 3, lo8 = (x8 * TMt) >> 3, ux = ((((x8 + 1) * TMt) >> 3) - lo8) * NTl;
    int nu = ux > s8 ? (ux - s8 + S8 - 1) / S8 : 0; if (nu > g8::MOE_MAX_UNITS) nu = g8::MOE_MAX_UNITS;
    if (tid < nu) { const int q = tid * S8 + s8, al = q / NTl, mg = lo8 + al; int pn = q % NTl; pn |= ((NTl == 8 ? pn + 2 * al : 2 * pn + al) & 7) << 8; int e = 0;
        for (int q = 1; q < 32; ++q) if (pt[q] <= mg) e = q;
        const int mt = mg - pt[e]; const int nv = min(256, cnt[e] - mt * 256);
        desc[4 * tid] = e; desc[4 * tid + 1] = mg; desc[4 * tid + 2] = nv | (mt << 16); desc[4 * tid + 3] = pn; }
    WG_SYNC();
    if (gather) {
        const int nt_ = nu < g8::MOE_TAB_UNITS ? nu : g8::MOE_TAB_UNITS;
        for (int i = tid; i < nt_ * 256; i += NTHR) { const int ui = i >> 8, r = i & 255; const int e = desc[4 * ui], nvm = desc[4 * ui + 2], nv = nvm & 0xffff, mt = nvm >> 16;
            tab[i] = r < nv ? (elist[e * CAP + mt * 256 + r] >> 2) * 1024 : 0; }
        if (nu > g8::MOE_TAB_UNITS) nu = g8::MOE_TAB_UNITS;
        WG_SYNC();
    } else {
        if (nu > 6) nu = 6;
        const float* gate = (const float*)(as_global(p.k->ws) + OFF_GATE); LAS float* tg = (LAS float*)(tab + 2048);
        for (int i = tid; i < nu * 256; i += NTHR) { const int ui = i >> 8, r = i & 255; const int e = desc[4 * ui], nvm = desc[4 * ui + 2], nv = nvm & 0xffff, mt = nvm >> 16;
            const int flat = r < nv ? elist[e * CAP + mt * 256 + r] : 0; tab[i] = flat; tg[i] = r < nv ? gate[flat] : 0.f; }
        WG_SYNC();
    }
    return __builtin_amdgcn_readfirstlane(nu);
}
enum { PH_PREP = 0, PH_MOD, PH_NORM0, PH_S5, PH_S5POST, PH_GLU, PH_SCIN, PH_CONV3, PH_SCOUT, PH_PW1, PH_CONV31, PH_PW2, PH_ROUTE, PH_MOE1, PH_MOE2, PH_COMBINE };

template <int PH> __device__ __forceinline__ void run_phase(const Cx& p_in, int l, LAS unsigned char* lds) {
    Cx p = p_in; asm volatile("" : "+s"(p.k));
    const int G = gridDim.x, c = blockIdx.x;
    if constexpr (PH == PH_PREP) ph_prep(p, lds);
    if constexpr (PH == PH_MOD) ph_mod(p, lds);
    if constexpr (PH == PH_NORM0) ph_norm_first(p);
    if constexpr (PH == PH_S5) ph_s5(p, l, lds);
    if constexpr (PH == PH_CONV3) ph_conv3(p);
    if constexpr (PH == PH_CONV31) ph_conv31(p, lds);
    if constexpr (PH == PH_ROUTE) { if (l > 0) { const int pk = (l - 1) % 3; const int covered = pk == 0 ? tail_cap(68 * 8, G) : pk == 1 ? tail_cap(68 * 12, G) + tail_cap(68 * 4, G) : tail_cap(68 * 8, G) + tail_cap(68 * 4, G);
            conv_catchup(p, lds, l, covered); }
        ph_route(p, l, lds); }
    if constexpr (PH == PH_COMBINE) ph_combine(p, l);
    if constexpr (PH == PH_GLU) { const bool last = (l == DEPTH - 1);
        g8::SchedDense8 S{p.k, OFF_WGLU + (size_t)(l / 3) * 2 * MiB, last ? RCTX : 0, last ? 64 : 68, 8, G, c}; g8::EpiGluRes E{p.k, l};
        g8::gemm_phase<g8::EpiGluRes, g8::SchedDense8, true>(lds, p.k, OFF_A2, S, E, p.wv);
        if (!last) tail_convert(p, lds, l + 1, 0, 68 * 8); }
    if constexpr (PH == PH_SCIN) { g8::SchedDense S{p.k, OFF_WSCIN, 0, 68, 12, G, c}; g8::EpiScin E{p.k}; g8::gemm_phase(lds, p.k, OFF_HN, S, E, p.wv); tail_convert(p, lds, l + 1, 0, 68 * 12); }
    if constexpr (PH == PH_SCOUT) { g8::SchedDense8 S{p.k, OFF_WSCOUT, 0, 68, 4, G, c}; g8::EpiRes E{p.k, l, -1}; g8::gemm_phase<g8::EpiRes, g8::SchedDense8, true>(lds, p.k, OFF_A2, S, E, p.wv); tail_convert(p, lds, l + 1, tail_cap(68 * 12, G), 68 * 4); }
    if constexpr (PH == PH_PW1) { g8::SchedDense8 S{p.k, OFF_WPW1, 0, 68, 8, G, c}; g8::EpiPairBf16<0> E{p.k, l}; g8::gemm_phase<g8::EpiPairBf16<0>, g8::SchedDense8, true>(lds, p.k, OFF_HN, S, E, p.wv); tail_convert(p, lds, l + 1, 0, 68 * 8); }
    if constexpr (PH == PH_PW2) { g8::SchedDense8 S{p.k, OFF_WPW2, 0, 68, 4, G, c}; g8::EpiRes E{p.k, l, I_PW2B}; g8::gemm_phase<g8::EpiRes, g8::SchedDense8, true>(lds, p.k, OFF_A2, S, E, p.wv); tail_convert(p, lds, l + 1, tail_cap(68 * 8, G), 68 * 4); }
    if constexpr (PH == PH_MOE1) { const int nu = moe_setup(p, l, lds, 8, true);
        g8::SchedMoe S{p.k, OFF_WGU + (size_t)l * 64 * MiB, (size_t)2 * MiB, (const LAS int*)(lds + LDS_MISC + 512), (const LAS int*)(lds + LDS_MISC + 1024), nu, true};
        g8::EpiPairBf16<1> E{p.k, l}; g8::gemm_phase<g8::EpiPairBf16<1>, g8::SchedMoe, true>(lds, p.k, OFF_F, S, E, p.wv); }
    if constexpr (PH == PH_MOE2) { const int nu = moe_setup(p, l, lds, 4, false);
        g8::SchedMoe S{p.k, OFF_WD + (size_t)l * 32 * MiB, (size_t)1 * MiB, (const LAS int*)(lds + LDS_MISC + 512), (const LAS int*)(lds + LDS_MISC + 1024), nu, false};
        g8::EpiMoe2 E{p.k, l, (const LAS int*)(lds + LDS_MISC + 1024), (const LAS float*)(lds + LDS_MISC + 1024 + 8192)}; g8::gemm_phase<g8::EpiMoe2, g8::SchedMoe, true>(lds, p.k, OFF_HM, S, E, p.wv); }
}

#define NO_PK_F32 __attribute__((target("no-packed-fp32-ops")))
template <int PH> __global__ void NO_PK_F32 __launch_bounds__(NTHR, 2) k_ph(P p0, int l) {
    extern __shared__ __attribute__((aligned(16))) unsigned char shm[];
    Cx p; p.k = (KP)__builtin_amdgcn_kernarg_segment_ptr(); p.wv = __builtin_amdgcn_readfirstlane(threadIdx.x >> 6);
    run_phase<PH>(p, l, (LAS unsigned char*)shm);
}
#ifndef MK_MULTI
__global__ void NO_PK_F32 __launch_bounds__(NTHR, 2) fwd(P p0) {
    extern __shared__ __attribute__((aligned(16))) unsigned char shm[];
    LAS unsigned char* lds = (LAS unsigned char*)shm;
    Cx p; p.k = (KP)__builtin_amdgcn_kernarg_segment_ptr(); p.wv = __builtin_amdgcn_readfirstlane(threadIdx.x >> 6);
    volatile LAS unsigned* bst = (volatile LAS unsigned*)(lds + LDS_MISC + 256);
    if (threadIdx.x == 0) { bst[0] = 0u; bst[1] = 0u; bst[2] = 0u; bst[3] = 0u; }
    WG_SYNC();
    (void)xcd_barrier_post((unsigned*)(as_global(p.k->ws) + OFF_CTL) + CW_BAR, bst);
#define GRID_BAR() do { XcdBarrier b_; b_.bar = (unsigned*)(as_global(p.k->ws) + OFF_CTL) + CW_BAR; b_.x = xb_xcc_id(); b_.st = (volatile LAS unsigned*)(lds + LDS_MISC + 256); xcd_barrier(b_, p.wv); } while (0)
    run_phase<PH_PREP>(p, 0, lds); WG_SYNC();
    run_phase<PH_MOD>(p, 0, lds); WG_SYNC();
    GRID_BAR();
    run_phase<PH_NORM0>(p, 0, lds);
    GRID_BAR();
#define LAYER(l) do { constexpr int kind = (l) % 3; \
        if constexpr (kind == 0) { run_phase<PH_S5>(p, l, lds); GRID_BAR(); run_phase<PH_GLU>(p, l, lds); GRID_BAR(); } \
        else if constexpr (kind == 1) { run_phase<PH_SCIN>(p, l, lds); GRID_BAR(); run_phase<PH_CONV3>(p, l, lds); GRID_BAR(); run_phase<PH_SCOUT>(p, l, lds); GRID_BAR(); } \
        else { run_phase<PH_PW1>(p, l, lds); GRID_BAR(); run_phase<PH_CONV31>(p, l, lds); GRID_BAR(); run_phase<PH_PW2>(p, l, lds); GRID_BAR(); } \
        run_phase<PH_ROUTE>(p, l, lds); GRID_BAR(); \
        run_phase<PH_MOE1>(p, l, lds); GRID_BAR(); \
        run_phase<PH_MOE2>(p, l, lds); GRID_BAR(); \
        run_phase<PH_COMBINE>(p, l, lds); \
        if constexpr ((l) + 1 < DEPTH) GRID_BAR(); } while (0)
    LAYER(0); LAYER(1); LAYER(2); LAYER(3);
#undef LAYER
#undef GRID_BAR
}
#endif

template <int PH> static void launch(const P& p, int l, int grid, hipStream_t s) {
    static bool attr = false;
    if (!attr) { (void)hipFuncSetAttribute((const void*)k_ph<PH>, hipFuncAttributeMaxDynamicSharedMemorySize, LDS_BYTES); attr = true; }
    hipLaunchKernelGGL(k_ph<PH>, dim3(grid), dim3(NTHR), LDS_BYTES, s, p, l);
}
extern "C" void kernel_launch(void* const* d_in, const int* in_sizes, int n_in, void* d_out, int out_size, void* d_ws, size_t ws_size, hipStream_t stream) {
    if (n_in != N_IN || ws_size < WS_END || out_size != RLAT * D) { fprintf(stderr, "kernel_launch: unexpected problem: n_in %d ws %zu out %d\n", n_in, ws_size, out_size); return; }
    P p{};
    for (int i = 0; i < N_IN; ++i) p.in[i] = (const float*)d_in[i];
    p.out = (float*)d_out; p.ws = (unsigned char*)d_ws;
    (void)hipMemsetAsync((char*)d_ws + OFF_CTL, 0, CTL_BYTES, stream);
#ifndef MK_MULTI
    static int grid = 0;
    if (!grid) {
        int dev = 0, cus = 0, per_cu = 0;
        (void)hipGetDevice(&dev); (void)hipDeviceGetAttribute(&cus, hipDeviceAttributeMultiprocessorCount, dev);
        (void)hipFuncSetAttribute((const void*)fwd, hipFuncAttributeMaxDynamicSharedMemorySize, LDS_BYTES);
        if (hipOccupancyMaxActiveBlocksPerMultiprocessor(&per_cu, (const void*)fwd, NTHR, LDS_BYTES) != hipSuccess || per_cu < 1) fprintf(stderr, "kernel_launch: occupancy query says %d blocks per CU\n", per_cu);
        (void)hipGetLastError();
        grid = cus >= 8 ? (cus & ~7) : 256;
    }
    hipLaunchKernelGGL(fwd, dim3(grid), dim3(NTHR), LDS_BYTES, stream, p);
    return;
#endif
    const int G = 256;
    launch<PH_PREP>(p, 0, G, stream);
    launch<PH_MOD>(p, 0, G, stream);
    launch<PH_NORM0>(p, 0, G, stream);
    for (int l = 0; l < DEPTH; ++l) {
        const int kind = l % 3;
        if (kind == 0) { launch<PH_S5>(p, l, G, stream); launch<PH_GLU>(p, l, G, stream); }
        else if (kind == 1) { launch<PH_SCIN>(p, l, G, stream); launch<PH_CONV3>(p, l, G, stream); launch<PH_SCOUT>(p, l, G, stream); }
        else { launch<PH_PW1>(p, l, G, stream); launch<PH_CONV31>(p, l, G, stream); launch<PH_PW2>(p, l, G, stream); }
        launch<PH_ROUTE>(p, l, G, stream);
        launch<PH_MOE1>(p, l, G, stream);
        launch<PH_MOE2>(p, l, G, stream);
        launch<PH_COMBINE>(p, l, G, stream);
    }
}
```
